# Optimizing an MI355X kernel written in HIP

```python
import math
import jax, jax.numpy as jnp
from jax import lax
import numpy as np

D_MODEL = 1024
BATCH = 8
SEQ = 4096
DEPTH = 1

HEAD_DIM = 64
HEADS_PER_GROUP = 8
ATTN_GROUPS = ((128, 1), (512, 4), (2048, 16))
N_GROUPS = len(ATTN_GROUPS)
N_ATTN_HEADS = N_GROUPS * HEADS_PER_GROUP
ATTN_WIDTH = HEADS_PER_GROUP * HEAD_DIM
QKV_WIDTH = N_GROUPS * 3 * ATTN_WIDTH
BLOCK = 128
POOL_WINDOWS = (2, 4, 8, 16)
POOL_GROUPS = len(POOL_WINDOWS)
POOL_WIDTH = D_MODEL // 2
PGW = POOL_WIDTH // POOL_GROUPS
NUM_BUCKETS = 32
MAX_DISTANCE = 2048
EPS = 1e-6
SPLIT_SIZES = (QKV_WIDTH, ATTN_WIDTH, POOL_WIDTH, POOL_WIDTH, D_MODEL, D_MODEL)
SPLIT_POINTS = (QKV_WIDTH,
                QKV_WIDTH + ATTN_WIDTH,
                QKV_WIDTH + ATTN_WIDTH + POOL_WIDTH,
                QKV_WIDTH + ATTN_WIDTH + 2 * POOL_WIDTH,
                QKV_WIDTH + ATTN_WIDTH + 2 * POOL_WIDTH + D_MODEL)
IN_WIDTH = QKV_WIDTH + ATTN_WIDTH + 2 * POOL_WIDTH + 2 * D_MODEL

kernel_name = "hybrid_dilated_attn_pool_gated_block"


def rmsnorm(x, g):
    xf = x.astype(jnp.float32)
    y = xf * lax.rsqrt(jnp.mean(xf * xf, axis=-1, keepdims=True) + EPS)
    return (y * g.astype(jnp.float32)).astype(x.dtype)


def t5_bucket(n):
    max_exact = NUM_BUCKETS // 2
    nf = jnp.maximum(n, 1).astype(jnp.float32)
    large = max_exact + (jnp.log(nf / max_exact) / math.log(MAX_DISTANCE / max_exact)
                         * (NUM_BUCKETS - max_exact)).astype(jnp.int32)
    large = jnp.minimum(large, NUM_BUCKETS - 1)
    return jnp.where(n < max_exact, n, large)


def to_sub(t, dil):
    B, S = t.shape[:2]
    L = S // dil
    t = t.reshape((B, L, dil) + t.shape[2:])
    t = jnp.moveaxis(t, 2, 1)
    return t.reshape((B * dil, L) + t.shape[3:])


def from_sub(t, B, dil):
    L = t.shape[1]
    t = t.reshape((B, dil, L) + t.shape[2:])
    t = jnp.moveaxis(t, 1, 2)
    return t.reshape((B, L * dil) + t.shape[3:])


def dilated_window_attention(q, k, v, dil, n_back, bias_g):
    B, S, H, Dh = q.shape
    L = S // dil
    nb = -(-L // BLOCK)
    pad = nb * BLOCK - L
    Bd = B * dil

    def sub(t):
        return jnp.pad(to_sub(t, dil), ((0, 0), (0, pad), (0, 0), (0, 0)))

    def band(t):
        tp = jnp.pad(t, ((0, 0), (BLOCK, 0), (0, 0), (0, 0)))
        prev = tp[:, :-BLOCK].reshape(Bd, nb, BLOCK, H, Dh)
        cur = t.reshape(Bd, nb, BLOCK, H, Dh)
        return jnp.concatenate([prev, cur], axis=2)

    qb = sub(q).reshape(Bd, nb, BLOCK, H, Dh)
    kb = band(sub(k))
    vb = band(sub(v))

    i = jnp.arange(BLOCK)[:, None]
    j = jnp.arange(2 * BLOCK)[None, :]
    dist = BLOCK + i - j
    band_ok = (dist >= 0) & (dist <= n_back)
    key_ok = (jnp.arange(nb)[:, None, None] * BLOCK - BLOCK + j[None]) >= 0
    mask = band_ok[None] & key_ok
    bucket = t5_bucket(jnp.clip(dist, 0, n_back) * dil)
    bias = jnp.transpose(bias_g[bucket].astype(jnp.float32), (2, 0, 1))

    logits = jnp.einsum('znqhd,znkhd->znhqk', qb, kb).astype(jnp.float32) * (HEAD_DIM ** -0.5)
    logits = jnp.where(mask[None, :, None], logits + bias[None, None], -jnp.inf)
    m = jnp.max(logits, axis=-1, keepdims=True)
    p = jnp.exp(logits - m)
    denom = jnp.sum(p, axis=-1)
    o = jnp.einsum('znhqk,znkhd->znqhd', p.astype(vb.dtype), vb).astype(jnp.float32)
    o = o / jnp.moveaxis(denom, 2, 3)[..., None]
    lse = jnp.moveaxis(m[..., 0] + jnp.log(denom), 2, 3)

    o = o.reshape(Bd, nb * BLOCK, H, Dh)[:, :L]
    lse = lse.reshape(Bd, nb * BLOCK, H)[:, :L]
    return from_sub(o, B, dil), from_sub(lse, B, dil)


def multiscale_pool(u):
    B, S, C = u.shape
    uf = u.astype(jnp.float32)
    csp = jnp.pad(jnp.cumsum(uf, axis=1), ((0, 0), (1, 0), (0, 0)))
    t = jnp.arange(S)
    outs = []
    for g, win in enumerate(POOL_WINDOWS):
        cg = csp[:, :, g * PGW:(g + 1) * PGW]
        lo = jnp.maximum(t + 1 - win, 0)
        s = cg[:, 1:] - cg[:, lo]
        cnt = jnp.minimum(t + 1, win).astype(jnp.float32)
        outs.append(s / cnt[None, :, None])
    return jnp.concatenate(outs, axis=-1) - uf


def setup_inputs(seed: int = 0) -> dict:
    key = jax.random.key(seed)
    ks = jax.random.split(key, 14)
    f32 = jnp.float32
    nrm = lambda k, shape, s: (jax.random.normal(k, shape, f32) * s).astype(f32)
    return {
        "x": nrm(ks[0], (BATCH, SEQ, D_MODEL), 1.0),
        "c": nrm(ks[1], (BATCH, D_MODEL), 1.0),
        "norm_g": 1.0 + nrm(ks[2], (DEPTH, D_MODEL), 0.05),
        "w_ada": nrm(ks[3], (DEPTH, D_MODEL, 3 * D_MODEL), 0.5 * D_MODEL ** -0.5),
        "b_ada": nrm(ks[4], (DEPTH, 3 * D_MODEL), 0.01),
        "w_in": nrm(ks[5], (DEPTH, D_MODEL, IN_WIDTH), D_MODEL ** -0.5),
        "pool_w": nrm(ks[6], (DEPTH, POOL_GROUPS, PGW, PGW), PGW ** -0.5),
        "pool_scale": 1.0 + nrm(ks[7], (DEPTH, POOL_WIDTH), 0.1),
        "w_attn_br": nrm(ks[8], (DEPTH, ATTN_WIDTH, D_MODEL), ATTN_WIDTH ** -0.5),
        "w_pool_br": nrm(ks[9], (DEPTH, POOL_WIDTH, D_MODEL), POOL_WIDTH ** -0.5),
        "w_out": nrm(ks[10], (DEPTH, D_MODEL, D_MODEL), D_MODEL ** -0.5),
        "rel_bias": nrm(ks[11], (NUM_BUCKETS, N_ATTN_HEADS), 0.5),
        "final_g": 1.0 + nrm(ks[12], (D_MODEL,), 0.05),
    }


def reference(x, c, norm_g, w_ada, b_ada, w_in, pool_w, pool_scale, w_attn_br, w_pool_br, w_out, rel_bias, final_g):
    B, S, D = x.shape
    for l in range(DEPTH):
        mod = c @ w_ada[l] + b_ada[l]
        shift, scale, gate = jnp.split(mod, 3, axis=-1)
        h = rmsnorm(x, norm_g[l]) * (1.0 + scale[:, None]) + shift[:, None]

        proj = h @ w_in[l]
        qkv, z_attn, u_pool, z_pool, g_attn, g_pool = jnp.split(proj, SPLIT_POINTS, axis=-1)
        qkv = qkv.reshape(B, S, N_GROUPS, 3, HEADS_PER_GROUP, HEAD_DIM)

        outs, lses = [], []
        for gi, (win, dil) in enumerate(ATTN_GROUPS):
            bias_g = rel_bias[:, gi * HEADS_PER_GROUP:(gi + 1) * HEADS_PER_GROUP]
            o, lse = dilated_window_attention(qkv[:, :, gi, 0], qkv[:, :, gi, 1], qkv[:, :, gi, 2],
                                              dil, win // dil, bias_g)
            outs.append(o)
            lses.append(lse)
        wts = jax.nn.softmax(jnp.stack(lses, axis=0), axis=0)
        attn = jnp.sum(wts[..., None] * jnp.stack(outs, axis=0), axis=0)
        attn = attn.reshape(B, S, ATTN_WIDTH).astype(x.dtype)
        y_attn = (attn * jax.nn.silu(z_attn)) @ w_attn_br[l]

        pooled = multiscale_pool(u_pool).reshape(B, S, POOL_GROUPS, PGW)
        mixed = jnp.einsum('bsgc,gce->bsge', pooled, pool_w[l].astype(jnp.float32))
        mixed = (mixed.reshape(B, S, POOL_WIDTH) * pool_scale[l]).astype(x.dtype)
        y_pool = (mixed * jax.nn.silu(z_pool)) @ w_pool_br[l]

        merged = jax.nn.sigmoid(g_attn) * y_attn + jax.nn.sigmoid(g_pool) * y_pool
        x = x + gate[:, None] * (merged @ w_out[l])
    return rmsnorm(x, final_g)
```

```cpp
#include <hip/hip_runtime.h>
#include <cstdio>
#include <cstdint>

#ifndef PROBE_DUP
#define PROBE_DUP 0
#endif
#ifndef PROBE_SUB
#define PROBE_SUB 1
#endif
#ifndef MK_N_LAUNCHES
#define MK_N_LAUNCHES 1
#endif

constexpr int BATCH = 8, SEQ = 4096, DM = 1024, NTOK = BATCH * SEQ;
constexpr int INW = 8192, NMAIN = 6656, NVT = 1536;
constexpr float EPS = 1e-6f;
constexpr float LOG2E = 1.4426950408889634f;
constexpr float QSCALE = 0.125f * LOG2E;
constexpr float NEG_BIG = -1e30f;

namespace pg8 {
#define PG8_LAS __attribute__((address_space(3)))
typedef unsigned short bf16_t;
typedef short bf16x8 __attribute__((ext_vector_type(8)));
typedef float f32x4 __attribute__((ext_vector_type(4)));
typedef unsigned u32x4 __attribute__((ext_vector_type(4)));
constexpr int BM = 256, BK = 64, HALF = 128, HTB = HALF * BK * 2, STAGE_BYTES = 8 * HTB, NXCD = 8, WGM = 8;

__host__ __device__ __forceinline__ int lds_byte(int r, int c) { const int st = (r >> 4) * 2 + (c >> 5), rr = r & 15, cc = c & 31, ob = rr * 64 + cc * 2; return st * 1024 + (ob ^ (((ob >> 9) & 1) << 5)); }
__host__ __device__ __forceinline__ void stage_rc(int b, int& R, int& C) { const int st = b / 1024, sb = b % 1024, swz = sb ^ (((sb >> 9) & 1) << 5); R = (st >> 1) * 16 + swz / 64; C = (st & 1) * 32 + (swz % 64) / 2; }
__host__ __device__ __forceinline__ int perm32(int rho) { const int n = rho >> 4, i = rho & 15; return 8 * (i >> 2) + 4 * n + (i & 3); }
__host__ __device__ __forceinline__ int tau16(int k) { return ((k & 4) << 1) | ((k & 8) >> 1) | (k & 3); }
template <int BMODE> __host__ __device__ __forceinline__ int bmap(int Rb) {
    if (BMODE == 1) return 16 * (Rb >> 4) + tau16(Rb & 15);
    if (BMODE == 4) { const int blkh = Rb >> 4, lbl = blkh >> 2, r = blkh & 3; return (16 * lbl + tau16(Rb & 15)) * 4 + r; }
    if (BMODE == 16) return tau16(Rb & 15) * 16 + (Rb >> 4);
    return Rb;
}

struct Unit { int pm, pn; };
struct Gemm { const bf16_t* A; const bf16_t* Bt; int M, N, K; };

struct StaticOrder {
    int nM, nN, nwg, G, c;
    __host__ __device__ void init(int M, int N, int G_, int c_) { nM = M / BM; nN = N / BM; nwg = nM * nN; G = G_; c = c_; }
    __host__ __device__ bool next(int i, Unit& u) const {
        const long L = (long)i * G + c; if (L >= nwg) return false;
        int wgid = (int)L; { const int q = nwg / NXCD, r = nwg % NXCD, xcd = wgid % NXCD, off = wgid / NXCD; wgid = (xcd < r ? xcd * (q + 1) : r * (q + 1) + (xcd - r) * q) + off; }
        const int nig = WGM * nN, gid = wgid / nig, fm = gid * WGM, gsz = (nM - fm) < WGM ? (nM - fm) : WGM;
        u.pm = fm + ((wgid % nig) % gsz); u.pn = (wgid % nig) / gsz; return true;
    }
    __device__ __forceinline__ void a_ready(const Unit&) const {}
    __device__ __forceinline__ void done(const Unit&) const {}
};

__device__ __forceinline__ unsigned cvt_pk_bf16(float lo, float hi) { unsigned r; asm volatile("s_nop 1\n\tv_cvt_pk_bf16_f32 %0, %1, %2" : "=v"(r) : "v"(lo), "v"(hi)); return r; }
__device__ __forceinline__ float bf_lo(unsigned w) { return __uint_as_float(w << 16); }
__device__ __forceinline__ float bf_hi(unsigned w) { return __uint_as_float(w & 0xffff0000u); }
__device__ __forceinline__ float sigm(float v) { return __builtin_amdgcn_rcpf(1.f + __builtin_amdgcn_exp2f(-LOG2E * v)); }


constexpr size_t ABUF = (size_t)NTOK * 512;
struct EpiProj {
    static constexpr bool PERM = true, AFTER_DRAIN = false;
    bf16_t* act; bf16_t* sg;
    __device__ __forceinline__ void operator()(const f32x4 (&acc)[2][2][4][2], const Unit& u, int wr, int wc, int fr, int fq) const {
        const int pn = u.pn;
        if (pn < 12) {
            const int g = pn >> 2, type = (pn >> 1) & 1, sh = 2 * g, NB = 128 >> sh; char* base = (char*)(act + (size_t)(g * 3 + type) * ABUF);
            const float sc = type == 0 ? QSCALE : 1.f;
            const int b = u.pm >> 4, tt0 = (u.pm & 15) * 256 + wr * 64 + fr;
            const int dkhi = ((wc & 1) * 2 + (fq >> 1)) * 1024 + (fq & 1) * 512;
#pragma unroll
            for (int ai = 0; ai < 2; ++ai)
#pragma unroll
                for (int m = 0; m < 4; ++m) { const int tt = tt0 + ai * HALF + m * 16, r = tt & ((1 << sh) - 1), l = tt >> sh;
                    const int blk0 = (b * 8) * 128 + r * NB + (l >> 5); const int inb = dkhi + (l & 31) * 16;
#pragma unroll
                    for (int bj = 0; bj < 2; ++bj) { const int h = (pn & 1) * 4 + bj * 2 + (wc >> 1);
                        const f32x4 v0 = acc[ai][bj][m][0] * sc, v1 = acc[ai][bj][m][1] * sc;
                        u32x4 w; w.x = cvt_pk_bf16(v0[0], v0[1]); w.y = cvt_pk_bf16(v0[2], v0[3]); w.z = cvt_pk_bf16(v1[0], v1[1]); w.w = cvt_pk_bf16(v1[2], v1[3]);
                        *(u32x4*)(base + ((size_t)(blk0 + h * 128) << 12) + inb) = w; } }
            return;
        }
        if (pn < 18) {
            const int j = (pn - 12) >> 1; bf16_t* base = act + (size_t)9 * ABUF + (j == 1 ? 2 * ABUF : (j == 2 ? ABUF : 0));
            const int row0 = u.pm * BM + wr * 64 + fr;
#pragma unroll
            for (int ai = 0; ai < 2; ++ai)
#pragma unroll
                for (int m = 0; m < 4; ++m) { const int tok = row0 + ai * HALF + m * 16;
#pragma unroll
                    for (int bj = 0; bj < 2; ++bj) { const int c8 = (pn & 1) * 32 + bj * 16 + wc * 4 + fq; f32x4 v0 = acc[ai][bj][m][0], v1 = acc[ai][bj][m][1];
                        if (j != 1) {
#pragma unroll
                            for (int e = 0; e < 4; ++e) { v0[e] = v0[e] * sigm(v0[e]); v1[e] = v1[e] * sigm(v1[e]); } }
                        u32x4 w; w.x = cvt_pk_bf16(v0[0], v0[1]); w.y = cvt_pk_bf16(v0[2], v0[3]); w.z = cvt_pk_bf16(v1[0], v1[1]); w.w = cvt_pk_bf16(v1[2], v1[3]);
                        *(u32x4*)(base + ((size_t)c8 * NTOK + tok) * 8) = w; } }
            return;
        }
        bf16_t* base; int ldc, colt, mode;
        { const int j = (pn - 18) >> 2; base = sg + (size_t)j * ((size_t)NTOK * 1024); ldc = 1024; colt = ((pn - 18) & 3) * 256; mode = 3; }
        const int row0 = u.pm * BM + wr * 64 + fr, col0 = colt + wc * 32 + 8 * fq;
#pragma unroll
        for (int ai = 0; ai < 2; ++ai)
#pragma unroll
            for (int m = 0; m < 4; ++m) { bf16_t* rowp = base + (size_t)(row0 + ai * HALF + m * 16) * ldc + col0;
#pragma unroll
                for (int bj = 0; bj < 2; ++bj) { f32x4 v0 = acc[ai][bj][m][0], v1 = acc[ai][bj][m][1];
                    if (mode == 2) {
#pragma unroll
                        for (int e = 0; e < 4; ++e) { v0[e] = v0[e] * sigm(v0[e]); v1[e] = v1[e] * sigm(v1[e]); } }
                    else if (mode == 3) {
#pragma unroll
                        for (int e = 0; e < 4; ++e) { v0[e] = sigm(v0[e]); v1[e] = sigm(v1[e]); } }
                    u32x4 w; w.x = cvt_pk_bf16(v0[0], v0[1]); w.y = cvt_pk_bf16(v0[2], v0[3]); w.z = cvt_pk_bf16(v1[0], v1[1]); w.w = cvt_pk_bf16(v1[2], v1[3]);
                    *(u32x4*)(rowp + bj * HALF) = w; } }
    }
};
template <int DIL> struct EpiVT {
    static constexpr bool PERM = true, AFTER_DRAIN = false;
    bf16_t* VT;
    __device__ __forceinline__ void operator()(const f32x4 (&acc)[2][2][4][2], const Unit& u, int wr, int wc, int fr, int fq) const {
        const int pn = u.pn, b = pn >> 4;
#pragma unroll
        for (int bj = 0; bj < 2; ++bj) {
            const int blk = bj * 8 + wc * 2 + (fq >> 1), h16 = fq & 1; int vb;
            if (DIL == 1) vb = 16 * (pn & 15) + blk;
            else if (DIL == 4) { const int lbl = blk >> 2, r = blk & 3; vb = r * 64 + 4 * (pn & 15) + lbl; }
            else vb = blk * 16 + (pn & 15);
#pragma unroll
            for (int ai = 0; ai < 2; ++ai) { const int h = u.pm * 4 + ai * 2 + wr;
                bf16_t* bp = VT + ((size_t)((b * 8 + h) * 256 + vb) << 10) + h16 * 8;
#pragma unroll
                for (int m = 0; m < 4; ++m) { const int d = m * 16 + fr;
                    const f32x4 v0 = acc[ai][bj][m][0], v1 = acc[ai][bj][m][1];
                    u32x4 w; w.x = cvt_pk_bf16(v0[0], v0[1]); w.y = cvt_pk_bf16(v0[2], v0[3]); w.z = cvt_pk_bf16(v1[0], v1[1]); w.w = cvt_pk_bf16(v1[2], v1[3]);
                    *(u32x4*)(bp + d * 16) = w; } }
        }
    }
};
struct EpiMix {
    static constexpr bool PERM = true, AFTER_DRAIN = false;
    bf16_t* ZP; const float* pscale; bf16_t* DST;
    __device__ __forceinline__ void operator()(const f32x4 (&acc)[2][2][4][2], const Unit& u, int wr, int wc, int fr, int fq) const {
        const int row0 = u.pm * BM + wr * 64 + fr, col0 = u.pn * BM + wc * 32 + 8 * fq;
        f32x4 sv[2][2];
#pragma unroll
        for (int bj = 0; bj < 2; ++bj)
#pragma unroll
            for (int n = 0; n < 2; ++n) sv[bj][n] = *(const f32x4*)(pscale + col0 + bj * HALF + 4 * n);
#pragma unroll
        for (int ai = 0; ai < 2; ++ai)
#pragma unroll
            for (int m = 0; m < 4; ++m) { bf16_t* rowp = ZP + (size_t)(row0 + ai * HALF + m * 16) * 512 + col0;
#pragma unroll
                for (int bj = 0; bj < 2; ++bj) { const u32x4 z = *(const u32x4*)(rowp + bj * HALF);
                    const f32x4 v0 = acc[ai][bj][m][0] * sv[bj][0], v1 = acc[ai][bj][m][1] * sv[bj][1];
                    u32x4 w; w.x = cvt_pk_bf16(v0[0] * bf_lo(z.x), v0[1] * bf_hi(z.x)); w.y = cvt_pk_bf16(v0[2] * bf_lo(z.y), v0[3] * bf_hi(z.y));
                    w.z = cvt_pk_bf16(v1[0] * bf_lo(z.z), v1[1] * bf_hi(z.z)); w.w = cvt_pk_bf16(v1[2] * bf_lo(z.w), v1[3] * bf_hi(z.w));
                    *(u32x4*)(DST + (rowp - ZP) + bj * HALF) = w; } }
    }
};
template <bool FIRST> struct EpiGate {
    static constexpr bool PERM = true, AFTER_DRAIN = false;
    const bf16_t* gate; const bf16_t* prev; bf16_t* out;
    __device__ __forceinline__ void operator()(const f32x4 (&acc)[2][2][4][2], const Unit& u, int wr, int wc, int fr, int fq) const {
        const int row0 = u.pm * BM + wr * 64 + fr, col0 = u.pn * BM + wc * 32 + 8 * fq;
#pragma unroll
        for (int ai = 0; ai < 2; ++ai)
#pragma unroll
            for (int m = 0; m < 4; ++m) { const size_t off = (size_t)(row0 + ai * HALF + m * 16) * 1024 + col0;
#pragma unroll
                for (int bj = 0; bj < 2; ++bj) { const u32x4 gt = *(const u32x4*)(gate + off + bj * HALF);
                    const f32x4 a0 = acc[ai][bj][m][0], a1 = acc[ai][bj][m][1];
                    float r[8] = {a0[0] * bf_lo(gt.x), a0[1] * bf_hi(gt.x), a0[2] * bf_lo(gt.y), a0[3] * bf_hi(gt.y), a1[0] * bf_lo(gt.z), a1[1] * bf_hi(gt.z), a1[2] * bf_lo(gt.w), a1[3] * bf_hi(gt.w)};
                    if (!FIRST) { const u32x4 p = *(const u32x4*)(prev + off + bj * HALF);
                        r[0] += bf_lo(p.x); r[1] += bf_hi(p.x); r[2] += bf_lo(p.y); r[3] += bf_hi(p.y); r[4] += bf_lo(p.z); r[5] += bf_hi(p.z); r[6] += bf_lo(p.w); r[7] += bf_hi(p.w); }
                    u32x4 w; w.x = cvt_pk_bf16(r[0], r[1]); w.y = cvt_pk_bf16(r[2], r[3]); w.z = cvt_pk_bf16(r[4], r[5]); w.w = cvt_pk_bf16(r[6], r[7]);
                    *(u32x4*)(out + off + bj * HALF) = w; } }
    }
};
struct EpiFinal {
    static constexpr bool PERM = false, AFTER_DRAIN = false;
    const float* x; float* out; const float* gate; float* rowsq;
    __device__ __forceinline__ void operator()(const f32x4 (&acc)[2][2][4][2], const Unit& u, int wr, int wc, int fr, int fq) const {
        const int row0 = u.pm * BM + wr * 64 + fr, col0 = u.pn * BM + wc * 32 + 4 * fq;
        const float* gp = gate + (size_t)((u.pm * BM) / SEQ) * 1024 + col0;
        f32x4 gv[2][2];
#pragma unroll
        for (int bj = 0; bj < 2; ++bj)
#pragma unroll
            for (int n = 0; n < 2; ++n) gv[bj][n] = *(const f32x4*)(gp + bj * HALF + n * 16);
#pragma unroll
        for (int ai = 0; ai < 2; ++ai)
#pragma unroll
            for (int m = 0; m < 4; ++m) { const int row = row0 + ai * HALF + m * 16; const size_t off = (size_t)row * 1024 + col0; float sq = 0.f;
#pragma unroll
                for (int bj = 0; bj < 2; ++bj)
#pragma unroll
                    for (int n = 0; n < 2; ++n) { const f32x4 xv = *(const f32x4*)(x + off + bj * HALF + n * 16); const f32x4 o = xv + gv[bj][n] * acc[ai][bj][m][n];
                        sq += (o[0] * o[0] + o[1] * o[1]) + (o[2] * o[2] + o[3] * o[3]); *(f32x4*)(out + off + bj * HALF + n * 16) = o; }
                sq += __shfl_xor(sq, 16); sq += __shfl_xor(sq, 32);
                if (fq == 0) rowsq[(size_t)row * 16 + u.pn * 4 + wc] = sq; }
    }
};

template <class Epi, class Sched, bool ALIGN_EPI = false, bool SP2 = false, int BMODE = 0, int AMODE = 0>
__device__ __forceinline__ void gemm_phase(PG8_LAS unsigned char* lds, const Gemm g, const Sched& S, const Epi& E) {
    const int tid = threadIdx.x, wid = __builtin_amdgcn_readfirstlane(tid >> 6), lane = tid & 63, wr = wid >> 2, wc = wid & 3, fr = lane & 15, fq = lane >> 4;
    const int K = g.K, nt = K / BK;
    unsigned voffA[2], voffB[2];
#pragma unroll
    for (int i = 0; i < 2; ++i) { int R, C; stage_rc(tid * 16 + i * 8192, R, C); const int Rb = Epi::PERM ? ((R & ~31) + perm32(R & 31)) : R;
        voffA[i] = AMODE == 1 ? (unsigned)((C >> 3) * NTOK + R) * 16u : (unsigned)(R * K + C) * 2u; voffB[i] = (unsigned)(bmap<BMODE>(Rb) * K + C) * 2u; }
    const size_t kstep = (size_t)(BK * 2);
    const size_t kstepA = AMODE == 1 ? (size_t)8 * NTOK * 16 : kstep;
    const size_t hstepB_nat = (size_t)HALF * K * 2;
    const size_t hstep = AMODE == 1 ? (size_t)HALF * 16 : hstepB_nat;
    const size_t hstepB = (BMODE == 16) ? (size_t)8 * K * 2 : hstepB_nat;
    const size_t tstep = 2 * hstep, tstepB = 2 * hstepB_nat;
    const unsigned ldsw = (unsigned)wid * 1024u;
    const int aoff = lds_byte(wr * 64 + fr, fq * 8), boff = lds_byte(wc * 32 + fr, fq * 8);
#define PG8_SA(b, h) (((b) * 2 + (h)) * HTB)
#define PG8_SB(b, h) ((4 + (b) * 2 + (h)) * HTB)
#define PG8_STAGE(bufoff, gbase, voff) do { _Pragma("unroll") for (int _i = 0; _i < 2; ++_i) \
        __builtin_amdgcn_global_load_lds((const unsigned*)((const char*)(gbase) + (voff)[_i]), (PG8_LAS unsigned*)(lds + (bufoff) + ldsw + _i * 8192), 16, 0, 0); } while (0)
#define PG8_LDA(dst, b, h) do { _Pragma("unroll") for (int m = 0; m < 4; ++m) _Pragma("unroll") for (int k = 0; k < 2; ++k) dst[m][k] = *(const PG8_LAS bf16x8*)(lds + PG8_SA(b, h) + aoff + m * 2048 + k * 1024); } while (0)
#define PG8_LDB(dst, b, h) do { _Pragma("unroll") for (int n = 0; n < 2; ++n) _Pragma("unroll") for (int k = 0; k < 2; ++k) dst[n][k] = *(const PG8_LAS bf16x8*)(lds + PG8_SB(b, h) + boff + n * 2048 + k * 1024); } while (0)
#define PG8_MMA(ai, bj, At, Bt) do { __builtin_amdgcn_s_setprio(1); _Pragma("unroll") for (int m = 0; m < 4; ++m) _Pragma("unroll") for (int n = 0; n < 2; ++n) _Pragma("unroll") for (int k = 0; k < 2; ++k) \
        acc[ai][bj][m][n] = __builtin_amdgcn_mfma_f32_16x16x32_bf16(Bt[n][k], At[m][k], acc[ai][bj][m][n], 0, 0, 0); __builtin_amdgcn_s_setprio(0); } while (0)
#define PG8_WAIT_V(n) asm volatile("s_waitcnt vmcnt(" #n ")" ::: "memory")
#define PG8_WAIT_L(n) asm volatile("s_waitcnt lgkmcnt(" #n ")" ::: "memory")
#define PG8_BAR __builtin_amdgcn_s_barrier()
#define PG8_SCHED __builtin_amdgcn_sched_barrier(0)
    Unit cur, nxt; int ui = 0;
    if (!S.next(0, cur)) return;
    f32x4 acc[2][2][4][2];
#pragma unroll
    for (int a = 0; a < 2; ++a)
#pragma unroll
        for (int b = 0; b < 2; ++b)
#pragma unroll
            for (int m = 0; m < 4; ++m)
#pragma unroll
                for (int n = 0; n < 2; ++n) acc[a][b][m][n] = (f32x4){0.f, 0.f, 0.f, 0.f};
    bf16x8 At[4][2], B0[2][2], B1[2][2];
    const char* cA = (const char*)g.A + (size_t)cur.pm * tstep; const char* cB = (const char*)g.Bt + (size_t)cur.pn * tstepB;
    S.a_ready(cur);
    if constexpr (SP2) {
        PG8_STAGE(PG8_SB(0, 0), cB, voffB); PG8_STAGE(PG8_SB(0, 1), cB + hstepB, voffB); PG8_STAGE(PG8_SA(0, 0), cA, voffA); PG8_STAGE(PG8_SA(0, 1), cA + hstep, voffA);
        if (wr == 1) PG8_BAR;
        PG8_WAIT_V(2); PG8_BAR;
        PG8_STAGE(PG8_SB(1, 0), cB + kstep, voffB); PG8_STAGE(PG8_SA(1, 0), cA + kstepA, voffA); PG8_STAGE(PG8_SB(1, 1), cB + hstepB + kstep, voffB);
        PG8_WAIT_V(6); PG8_BAR;
    } else {
        PG8_STAGE(PG8_SB(0, 0), cB, voffB); PG8_STAGE(PG8_SA(0, 0), cA, voffA); PG8_STAGE(PG8_SB(0, 1), cB + hstepB, voffB); PG8_STAGE(PG8_SA(0, 1), cA + hstep, voffA);
        if (wr == 1) PG8_BAR;
        PG8_WAIT_V(4); PG8_BAR;
        PG8_STAGE(PG8_SB(1, 0), cB + kstep, voffB); PG8_STAGE(PG8_SA(1, 0), cA + kstepA, voffA); PG8_STAGE(PG8_SB(1, 1), cB + hstepB + kstep, voffB);
        PG8_WAIT_V(6); PG8_BAR;
    }
    for (;;) {
        const bool has_next = S.next(ui + 1, nxt);
        const char* nA = has_next ? (const char*)g.A + (size_t)nxt.pm * tstep : cA; const char* nB = has_next ? (const char*)g.Bt + (size_t)nxt.pn * tstepB : cB;
        for (int t = 0; t < nt; t += 2) {
            const bool last = (t == nt - 2);
            const char* a1 = cA + (size_t)(t + 1) * kstepA;
            const char* a2 = last ? nA : cA + (size_t)(t + 2) * kstepA; const char* b2 = last ? nB : cB + (size_t)(t + 2) * kstep;
            const char* a3 = a2 + kstepA; const char* b3 = b2 + kstep;
            if (last && has_next) S.a_ready(nxt);
            if constexpr (SP2) {
            PG8_LDB(B0, 0, 0); PG8_LDB(B1, 0, 1); PG8_SCHED; PG8_LDA(At, 0, 0); PG8_STAGE(PG8_SA(1, 1), a1 + hstep, voffA);
            PG8_WAIT_V(8); PG8_WAIT_L(0); PG8_BAR; PG8_MMA(0, 0, At, B0); PG8_MMA(0, 1, At, B1); PG8_BAR; PG8_SCHED;
            PG8_LDA(At, 0, 1); PG8_STAGE(PG8_SB(0, 0), b2, voffB); PG8_STAGE(PG8_SB(0, 1), b2 + hstepB, voffB); PG8_STAGE(PG8_SA(0, 0), a2, voffA);
            PG8_WAIT_V(8); PG8_WAIT_L(0); PG8_BAR; PG8_MMA(1, 0, At, B0); PG8_MMA(1, 1, At, B1); PG8_BAR; PG8_SCHED;
            PG8_LDB(B0, 1, 0); PG8_LDB(B1, 1, 1); PG8_SCHED; PG8_LDA(At, 1, 0); PG8_STAGE(PG8_SA(0, 1), a2 + hstep, voffA);
            PG8_WAIT_V(8); PG8_WAIT_L(0); PG8_BAR; PG8_MMA(0, 0, At, B0); PG8_MMA(0, 1, At, B1); PG8_BAR; PG8_SCHED;
            PG8_LDA(At, 1, 1); PG8_STAGE(PG8_SB(1, 0), b3, voffB); PG8_STAGE(PG8_SB(1, 1), b3 + hstepB, voffB); PG8_STAGE(PG8_SA(1, 0), a3, voffA);
            PG8_WAIT_V(8); PG8_WAIT_L(0); PG8_BAR; PG8_MMA(1, 0, At, B0); PG8_MMA(1, 1, At, B1); PG8_BAR; PG8_SCHED;
            } else {
            PG8_LDB(B0, 0, 0); PG8_SCHED; PG8_LDA(At, 0, 0); PG8_STAGE(PG8_SA(1, 1), a1 + hstep, voffA);
            PG8_WAIT_L(8); PG8_BAR; PG8_WAIT_L(0); PG8_MMA(0, 0, At, B0); PG8_BAR; PG8_SCHED;
            PG8_LDB(B1, 0, 1); PG8_STAGE(PG8_SB(0, 0), b2, voffB);
            PG8_BAR; PG8_WAIT_L(0); PG8_MMA(0, 1, At, B1); PG8_BAR;
            PG8_LDA(At, 0, 1); PG8_STAGE(PG8_SA(0, 0), a2, voffA);
            PG8_BAR; PG8_WAIT_L(0); PG8_MMA(1, 0, At, B0); PG8_BAR; PG8_SCHED;
            PG8_STAGE(PG8_SB(0, 1), b2 + hstepB, voffB);
            PG8_WAIT_V(6); PG8_BAR; PG8_MMA(1, 1, At, B1); PG8_BAR;
            PG8_LDB(B0, 1, 0); PG8_SCHED; PG8_LDA(At, 1, 0); PG8_STAGE(PG8_SA(0, 1), a2 + hstep, voffA);
            PG8_WAIT_L(8); PG8_BAR; PG8_WAIT_L(0); PG8_MMA(0, 0, At, B0); PG8_BAR; PG8_SCHED;
            PG8_LDB(B1, 1, 1); PG8_STAGE(PG8_SB(1, 0), b3, voffB);
            PG8_BAR; PG8_WAIT_L(0); PG8_MMA(0, 1, At, B1); PG8_BAR;
            PG8_LDA(At, 1, 1); PG8_STAGE(PG8_SA(1, 0), a3, voffA);
            PG8_BAR; PG8_WAIT_L(0); PG8_MMA(1, 0, At, B0); PG8_BAR; PG8_SCHED;
            PG8_STAGE(PG8_SB(1, 1), b3 + hstepB, voffB);
            PG8_WAIT_V(6); PG8_BAR; PG8_MMA(1, 1, At, B1); PG8_BAR;
            }
        }
        if constexpr (ALIGN_EPI) { if (wr == 0) PG8_BAR; }
        if constexpr (!Epi::AFTER_DRAIN) { E(acc, cur, wr, wc, fr, fq); S.done(cur); }
        if (!has_next) break;
#pragma unroll
        for (int a = 0; a < 2; ++a)
#pragma unroll
            for (int b = 0; b < 2; ++b)
#pragma unroll
                for (int m = 0; m < 4; ++m)
#pragma unroll
                    for (int n = 0; n < 2; ++n) acc[a][b][m][n] = (f32x4){0.f, 0.f, 0.f, 0.f};
        cur = nxt; cA = nA; cB = nB; ++ui;
        if constexpr (ALIGN_EPI) { if (wr == 1) PG8_BAR; }
    }
    PG8_WAIT_V(0);
    if constexpr (!ALIGN_EPI) { if (wr == 0) PG8_BAR; }
    PG8_BAR;
#undef PG8_SA
#undef PG8_SB
#undef PG8_STAGE
#undef PG8_LDA
#undef PG8_LDB
#undef PG8_MMA
#undef PG8_WAIT_V
#undef PG8_WAIT_L
#undef PG8_BAR
#undef PG8_SCHED
}
}

constexpr int NWAVES = 8;
constexpr int N_LAUNCHES = MK_N_LAUNCHES;
constexpr int NPHASE = 8;

constexpr size_t MiB = 1u << 20;
constexpr size_t WS_CTL = 0, CTL_ZERO_BYTES = 1 * MiB;
constexpr size_t WS_MODP = 1 * MiB;
constexpr size_t WS_MOD = 4 * MiB;
constexpr size_t WS_BT = 4 * MiB + 256 * 1024;
constexpr size_t WS_ROWSQ = 5 * MiB;
constexpr size_t WS_LSE = 8 * MiB;
constexpr size_t WS_WMAIN = 16 * MiB;
constexpr size_t WS_WV = WS_WMAIN + (size_t)NMAIN * 1024 * 2;
constexpr size_t WS_WATT = 32 * MiB, WS_WPOOL = 33 * MiB, WS_WOUT = 34 * MiB, WS_PWBD = 36 * MiB;
constexpr size_t WS_H = 40 * MiB;
constexpr size_t WS_ACT = 104 * MiB;
constexpr size_t WS_END = 512 * MiB;
constexpr size_t ABYTES = 32 * MiB;
constexpr size_t WS_PART = WS_ACT + 1 * ABYTES;
constexpr size_t WS_MG = WS_ACT + 4 * ABYTES;
constexpr size_t WS_DUMMY = WS_H + 32 * MiB;
constexpr int CW_BAR = 4096;

#define GAS __attribute__((address_space(1)))
#define LAS __attribute__((address_space(3)))
typedef unsigned short bf16;
typedef unsigned v4u __attribute__((ext_vector_type(4)));
typedef unsigned v2u __attribute__((ext_vector_type(2)));
typedef float f32x4 __attribute__((ext_vector_type(4)));
typedef float f32x16 __attribute__((ext_vector_type(16)));
typedef short bf16x8 __attribute__((ext_vector_type(8)));
typedef GAS unsigned gu32;
#define RLX_AGENT __ATOMIC_RELAXED, __HIP_MEMORY_SCOPE_AGENT
#define LDS_WAIT() asm volatile("s_waitcnt lgkmcnt(0)" ::: "memory")
#define VM_WAIT() asm volatile("s_waitcnt vmcnt(0)" ::: "memory")

constexpr int RING_OFF = 0, RING_BYTES = 131072;
constexpr int LDSCTL_OFF = RING_BYTES, MISC_OFF = LDSCTL_OFF + 320;
constexpr int LDS_BYTES = 147456;

__device__ __forceinline__ unsigned pk2(float lo, float hi) { return pg8::cvt_pk_bf16(lo, hi); }
using pg8::bf_lo; using pg8::bf_hi;

#define XB_TMO      128
#define XB_XCNT(j)  (256  + 64 * (j))
#define XB_XSUB(j)  (1280 + 64 * (j))
#define XB_XGEN(j)  (2304 + 64 * (j))
#define XB_TOP      3328
#define XB_TOPGEN   3392
#define XCD_BAR_WORDS 3456
#define XB_SPIN_CAP (1u << 18)
__device__ __forceinline__ unsigned xb_ld(unsigned* p)              { return __hip_atomic_load(p, __ATOMIC_RELAXED, __HIP_MEMORY_SCOPE_AGENT); }
__device__ __forceinline__ unsigned xb_add(unsigned* p, unsigned v) { return __hip_atomic_fetch_add(p, v, __ATOMIC_RELAXED, __HIP_MEMORY_SCOPE_AGENT); }
__device__ __forceinline__ unsigned xb_xcc_id() { return (unsigned)__builtin_amdgcn_s_getreg((3 << 11) | 20) & 0xFu; }
#define XB_SPIN(cond, bar) do { unsigned _sp = 0; while (cond) { __builtin_amdgcn_s_sleep(1); \
    if ((++_sp & 255u) == 0u) { if (xb_ld(&(bar)[XB_TMO])) break; if (_sp > XB_SPIN_CAP) { atomicAdd(&(bar)[XB_TMO], 1u); break; } } } } while (0)
struct XcdBarrier { unsigned* bar; unsigned x; volatile LAS unsigned* st; };
__device__ __forceinline__ XcdBarrier xcd_barrier_post(unsigned* bar, volatile LAS unsigned* st) {
    XcdBarrier b; b.bar = bar; b.x = xb_xcc_id(); b.st = st;
    if (threadIdx.x == 0) (void)xb_add(&bar[XB_XCNT(b.x)], 1u);
    return b;
}
__device__ __forceinline__ void xcd_barrier_complete(unsigned* bar, unsigned x, unsigned& nloc, unsigned& nx) {
    const unsigned G = gridDim.x * gridDim.y * gridDim.z;
    unsigned sum, cnt, mine, sp = 0u;
    for (;;) {
        sum = 0u; cnt = 0u; mine = 0u;
#pragma unroll
        for (unsigned j = 0; j < 16; ++j) { const unsigned c = xb_ld(&bar[XB_XCNT(j)]); sum += c; cnt += (c > 0u) ? 1u : 0u; mine = (j == x) ? c : mine; }
        if (sum == G) break;
        __builtin_amdgcn_s_sleep(1);
        if ((++sp & 255u) == 0u) { if (xb_ld(&bar[XB_TMO])) break; if (sp > XB_SPIN_CAP) { atomicAdd(&bar[XB_TMO], 1u); break; } }
    }
    nloc = mine > 0u ? mine : 1u; nx = cnt > 0u ? cnt : 1u;
}
__device__ __forceinline__ void xcd_barrier(const XcdBarrier& b) {
    asm volatile("s_waitcnt vmcnt(0)" ::: "memory");
    __syncthreads();
    if (threadIdx.x == 0) {
        unsigned* bar = b.bar;
        __builtin_amdgcn_s_waitcnt(0);
        unsigned nloc = b.st[0], nx = b.st[1];
        if (nloc == 0u) { xcd_barrier_complete(bar, b.x, nloc, nx); b.st[0] = nloc; b.st[1] = nx; }
        const unsigned old = xb_add(&bar[XB_XSUB(b.x)], 1u);
        const unsigned gen = old / nloc;
        if (old + 1u == (gen + 1u) * nloc) {
            __builtin_amdgcn_fence(__ATOMIC_RELEASE, "agent");
            asm volatile("s_waitcnt vmcnt(0)" ::: "memory");
            const unsigned og = xb_add(&bar[XB_TOP], 1u);
            const unsigned tg = og / nx;
            if (og + 1u == (tg + 1u) * nx) xb_add(&bar[XB_TOPGEN], 1u);
            else XB_SPIN(xb_ld(&bar[XB_TOPGEN]) == tg, bar);
            __builtin_amdgcn_fence(__ATOMIC_ACQUIRE, "agent");
            xb_add(&bar[XB_XGEN(b.x)], 1u);
            asm volatile("s_waitcnt vmcnt(0)" ::: "memory");
        } else {
            XB_SPIN(xb_ld(&bar[XB_XGEN(b.x)]) == gen, bar);
            __builtin_amdgcn_fence(__ATOMIC_ACQUIRE, "agent");
            asm volatile("s_waitcnt vmcnt(0)" ::: "memory");
        }
    }
    __syncthreads();
}

struct Frame {
    LAS unsigned char* lds;
    volatile LAS unsigned* MISC;
    gu32* ctl;
    int tid, lane, wave;
    int vcu, G;
    unsigned char* ws;
};

__device__ __forceinline__ float wave_sum(float v) {
#pragma unroll
    for (int o = 1; o < 64; o <<= 1) v += __shfl_xor(v, o);
    return v;
}

__device__ __forceinline__ void transpose_item(const float* W, int K, int N, int k0, int n0, bf16* dstrow0, LAS float* scr, int lane) {
#pragma unroll 8
    for (int i = 0; i < 32; ++i) { const int kk = 2 * i + (lane >> 5); scr[kk * 33 + (lane & 31)] = W[(size_t)(k0 + kk) * N + n0 + (lane & 31)]; }
    LDS_WAIT(); asm volatile("" ::: "memory");
    const int c = lane & 7;
#pragma unroll
    for (int j = 0; j < 4; ++j) { const int n = (lane >> 3) + 8 * j; const LAS float* s = scr + (8 * c) * 33 + n;
        v4u o; o.x = pk2(s[0 * 33], s[1 * 33]); o.y = pk2(s[2 * 33], s[3 * 33]); o.z = pk2(s[4 * 33], s[5 * 33]); o.w = pk2(s[6 * 33], s[7 * 33]);
        *(GAS v4u*)(dstrow0 + (size_t)n * K + k0 + 8 * c) = o; }
    LDS_WAIT(); asm volatile("" ::: "memory");
}
__device__ __forceinline__ int win_dest_row(int n) {
    if (n < 4608) { const int g = n / 1536, rem = n % 1536, type = rem / 512, j = rem % 512;
        return type == 2 ? NMAIN + g * 512 + j : g * 1024 + type * 512 + j; }
    return 3072 + (n - 4608);
}
__device__ __forceinline__ int t5_bucket(int n) {
    if (n < 16) return n;
    int large = 16 + (int)(logf((float)n / 16.0f) / logf(128.0f) * 16.0f);
    return large < 31 ? large : 31;
}
__device__ __forceinline__ void p0_prologue(Frame& F, const float* const* in) {
    LAS float* scr = (LAS float*)(F.lds + RING_OFF + F.wave * 16384);
    const int gw = F.vcu * NWAVES + F.wave, NGW = F.G * NWAVES;
    const float* w_in = in[5]; const float* pool_w = in[6]; const float* w_att = in[8]; const float* w_pool = in[9]; const float* w_out = in[10];
    bf16* WMAIN = (bf16*)(F.ws + WS_WMAIN);
    constexpr int I_IN = (1024 / 64) * (INW / 32), I_BR = (512 / 64) * (1024 / 32), I_OUT = (1024 / 64) * (1024 / 32);
    constexpr int NITEMS = I_IN + 2 * I_BR + I_OUT;
    for (int it = gw; it < NITEMS; it += NGW) {
        int r = it;
        if (r < I_IN) { const int nblk = INW / 32, kb = r / nblk, nb = r % nblk; transpose_item(w_in, 1024, INW, 64 * kb, 32 * nb, WMAIN + (size_t)win_dest_row(32 * nb) * 1024, scr, F.lane); continue; } r -= I_IN;
        if (r < I_BR) { const int nblk = 1024 / 32, kb = r / nblk, nb = r % nblk; transpose_item(w_att, 512, 1024, 64 * kb, 32 * nb, (bf16*)(F.ws + WS_WATT) + (size_t)(32 * nb) * 512, scr, F.lane); continue; } r -= I_BR;
        if (r < I_BR) { const int nblk = 1024 / 32, kb = r / nblk, nb = r % nblk; transpose_item(w_pool, 512, 1024, 64 * kb, 32 * nb, (bf16*)(F.ws + WS_WPOOL) + (size_t)(32 * nb) * 512, scr, F.lane); continue; } r -= I_BR;
        { const int nblk = 1024 / 32, kb = r / nblk, nb = r % nblk; transpose_item(w_out, 1024, 1024, 64 * kb, 32 * nb, (bf16*)(F.ws + WS_WOUT) + (size_t)(32 * nb) * 1024, scr, F.lane); }
    }
    { const float* c = in[1]; const float* w_ada = in[3]; float* MODP = (float*)(F.ws + WS_MODP);
      for (int task = gw; task < 48 * 32; task += NGW) { const int cg = task % 48, kc = task / 48, col = cg * 64 + F.lane;
          float a[8];
#pragma unroll
          for (int b = 0; b < 8; ++b) a[b] = 0.f;
#pragma unroll 8
          for (int k = 0; k < 32; ++k) { const int kk = kc * 32 + k; const float w = w_ada[(size_t)kk * 3072 + col];
#pragma unroll
              for (int b = 0; b < 8; ++b) a[b] += c[b * 1024 + kk] * w; }
#pragma unroll
          for (int b = 0; b < 8; ++b) MODP[((size_t)kc * 8 + b) * 3072 + col] = a[b]; } }
    const int gt = gw * 64 + F.lane, NT = NGW * 64;
    { bf16* PW = (bf16*)(F.ws + WS_PWBD);
      for (int ch = gt; ch < 4 * 4 * 8 * 64; ch += NT) { const int ln = ch & 63, ks = (ch >> 6) & 7, et = (ch >> 9) & 3, g = ch >> 11, e = et * 32 + (ln & 31), c0 = 16 * ks + 8 * (ln >> 5);
          const float* p = pool_w + (size_t)g * 16384 + (size_t)c0 * 128 + e;
          v4u o; o.x = pk2(p[0], p[128]); o.y = pk2(p[256], p[384]); o.z = pk2(p[512], p[640]); o.w = pk2(p[768], p[896]);
          *(GAS v4u*)(PW + (size_t)ch * 8) = o; } }
    { const float* rel_bias = in[11]; float* BD = (float*)(F.ws + WS_BT);
      for (int e = gt; e < 24 * 129; e += NT) { const int gh = e / 129, dist = e % 129, g = gh >> 3; const int dil = g == 0 ? 1 : (g == 1 ? 4 : 16);
          BD[e] = rel_bias[t5_bucket(dist * dil) * 24 + gh] * LOG2E; } }
}

__device__ __forceinline__ void p1_hrows(Frame& F, const float* const* in) {
    const float* x = in[0]; const float* norm_g = in[2]; const float* b_ada = in[4];
    const float* MODP = (const float*)(F.ws + WS_MODP);
    LAS float* av = (LAS float*)(F.lds + RING_OFF); LAS float* sv = av + 1024;
    const int wg = blockIdx.x, b = wg >> 5;
    for (int k = F.tid; k < 1024; k += NWAVES * 64) { float sh = b_ada[k], sc = b_ada[1024 + k], gt = b_ada[2048 + k];
        for (int kc = 0; kc < 32; ++kc) { const float* p = MODP + ((size_t)kc * 8 + b) * 3072; sh += p[k]; sc += p[1024 + k]; gt += p[2048 + k]; }
        av[k] = norm_g[k] * (1.f + sc); sv[k] = sh;
        if ((wg & 31) == 0) ((float*)(F.ws + WS_MOD))[b * 1024 + k] = gt; }
    LDS_WAIT(); __syncthreads();
    bf16* H = (bf16*)(F.ws + WS_H);
    for (int i = 0; i < 16; i += 4) { const int row0 = wg * 128 + F.wave * 16 + i;
        f32x4 v[4][4]; float s[4];
#pragma unroll
        for (int rr = 0; rr < 4; ++rr) { const GAS f32x4* xr = (const GAS f32x4*)(x + (size_t)(row0 + rr) * 1024) + F.lane;
#pragma unroll
            for (int j = 0; j < 4; ++j) v[rr][j] = xr[64 * j]; }
#pragma unroll
        for (int rr = 0; rr < 4; ++rr) { float t = 0.f;
#pragma unroll
            for (int j = 0; j < 4; ++j) t += (v[rr][j].x * v[rr][j].x + v[rr][j].y * v[rr][j].y) + (v[rr][j].z * v[rr][j].z + v[rr][j].w * v[rr][j].w);
            s[rr] = t; }
#pragma unroll
        for (int o = 1; o < 64; o <<= 1) {
#pragma unroll
            for (int rr = 0; rr < 4; ++rr) s[rr] += __shfl_xor(s[rr], o); }
#pragma unroll
        for (int rr = 0; rr < 4; ++rr) { const float rstd = 1.f / sqrtf(s[rr] * (1.f / 1024.f) + EPS);
            GAS v2u* o8 = (GAS v2u*)(H + (size_t)(row0 + rr) * 1024) + F.lane;
#pragma unroll
            for (int j = 0; j < 4; ++j) { const int k = 4 * F.lane + 256 * j; const f32x4 a = *(const LAS f32x4*)(av + k), sh = *(const LAS f32x4*)(sv + k);
                v2u w; w.x = pk2(v[rr][j].x * rstd * a.x + sh.x, v[rr][j].y * rstd * a.y + sh.y); w.y = pk2(v[rr][j].z * rstd * a.z + sh.z, v[rr][j].w * rstd * a.w + sh.w); o8[64 * j] = w; } } }
    __syncthreads();
}

constexpr int ATT_TBL = 0;
constexpr float ATT_THR = 8.0f;
__device__ __forceinline__ float max3f(float a, float b, float c) { return fmaxf(fmaxf(a, b), c); }
__device__ __forceinline__ void attn_chain(int lane, int g, int cc, char* QT, const char* KT, const char* VT, float* LSE, const LAS float* tbl, bool dummy, char* odummy) {
    const int q = lane & 31, hi = lane >> 5;
    const int sh = 2 * g, NB = 128 >> sh, bh = cc >> 5, ci = cc & 31, r = ci >> (5 - sh), n0 = 4 * (ci & ((32 >> sh) - 1));
    const int tbase = bh * 128 + r * NB, vbase = bh * 256 + r * 2 * NB;
    const LAS float* tb = tbl + (g * 8 + (bh & 7)) * 192 + (31 - q + 4 * hi);
    const LAS float* nb_ = tbl + 24 * 192 + (31 - q + 4 * hi);
    const int koff = lane * 16, voff = q * 32 + hi * 16;
    bf16x8 kr[3][4], vr[3][4], qf[4], qn[4];
#define ATT_LOADKV(i) do { const int lt_ = n0 + (i) / 5 - 4 + (i) % 5; const int ltc_ = lt_ < 0 ? 0 : lt_; \
        const char* kp_ = KT + ((size_t)(tbase + ltc_) << 12) + koff; const char* vp_ = VT + ((size_t)(vbase + 2 * ltc_) << 11) + voff; \
        _Pragma("unroll") for (int x_ = 0; x_ < 4; ++x_) kr[(i) % 3][x_] = *(const bf16x8*)(kp_ + x_ * 1024); \
        _Pragma("unroll") for (int x_ = 0; x_ < 4; ++x_) vr[(i) % 3][x_] = *(const bf16x8*)(vp_ + x_ * 1024); } while (0)
    { const char* qp = QT + ((size_t)(tbase + n0) << 12) + koff;
#pragma unroll
      for (int x = 0; x < 4; ++x) qf[x] = *(const bf16x8*)(qp + x * 1024); }
    ATT_LOADKV(0); ATT_LOADKV(1);
    float m = -3.0e38f, l = 0.f; f32x16 o0 = {}, o1 = {};
#pragma unroll
    for (int i = 0; i < 20; ++i) {
        const int nb = i / 5, kt = i % 5, n = n0 + nb, lt = n - 4 + kt;
        if (i + 2 < 20) ATT_LOADKV(i + 2);
        if (kt == 0 && nb < 3) { const char* qp = QT + ((size_t)(tbase + n + 1) << 12) + koff;
#pragma unroll
            for (int x = 0; x < 4; ++x) qn[x] = *(const bf16x8*)(qp + x * 1024); }
        const LAS float* tsel = lt < 0 ? nb_ : tb;
        f32x16 c;
#pragma unroll
        for (int e = 0; e < 16; ++e) c[e] = tsel[32 * kt + (e & 3) + 8 * (e >> 2)];
#pragma unroll
        for (int x = 0; x < 4; ++x) c = __builtin_amdgcn_mfma_f32_32x32x16_bf16(kr[i % 3][x], qf[x], c, 0, 0, 0);
        float rm = max3f(c[0], c[1], c[2]);
#pragma unroll
        for (int e = 3; e < 15; e += 2) rm = max3f(rm, c[e], c[e + 1]);
        rm = fmaxf(rm, c[15]);
        { auto rr = __builtin_amdgcn_permlane32_swap(__float_as_uint(rm), __float_as_uint(rm), false, false); rm = fmaxf(__uint_as_float(rr[0]), __uint_as_float(rr[1])); }
        if (__any(rm > m + ATT_THR)) { const float mn = fmaxf(m, rm), al = __builtin_amdgcn_exp2f(m - mn); m = mn; l *= al;
#pragma unroll
            for (int e = 0; e < 16; ++e) { o0[e] *= al; o1[e] *= al; } }
        float ps = 0.f;
#pragma unroll
        for (int e = 0; e < 16; ++e) { c[e] = __builtin_amdgcn_exp2f(c[e] - m); ps += c[e]; }
        l += ps;
        v4u p0, p1;
        p0.x = pk2(c[0], c[1]); p0.y = pk2(c[2], c[3]); p0.z = pk2(c[4], c[5]); p0.w = pk2(c[6], c[7]);
        p1.x = pk2(c[8], c[9]); p1.y = pk2(c[10], c[11]); p1.z = pk2(c[12], c[13]); p1.w = pk2(c[14], c[15]);
        const bf16x8 pf0 = __builtin_bit_cast(bf16x8, p0), pf1 = __builtin_bit_cast(bf16x8, p1);
        o0 = __builtin_amdgcn_mfma_f32_32x32x16_bf16(vr[i % 3][0], pf0, o0, 0, 0, 0);
        o1 = __builtin_amdgcn_mfma_f32_32x32x16_bf16(vr[i % 3][1], pf0, o1, 0, 0, 0);
        o0 = __builtin_amdgcn_mfma_f32_32x32x16_bf16(vr[i % 3][2], pf1, o0, 0, 0, 0);
        o1 = __builtin_amdgcn_mfma_f32_32x32x16_bf16(vr[i % 3][3], pf1, o1, 0, 0, 0);
        if (kt == 4) {
            { auto rr = __builtin_amdgcn_permlane32_swap(__float_as_uint(l), __float_as_uint(l), false, false); l = __uint_as_float(rr[0]) + __uint_as_float(rr[1]); }
            const float inv = 1.f / l;
            char* op = (dummy ? odummy : QT) + ((size_t)(tbase + n) << 12) + q * 16 + hi * 8;
#pragma unroll
            for (int r4 = 0; r4 < 4; ++r4) {
                v2u w0; w0.x = pk2(o0[4 * r4] * inv, o0[4 * r4 + 1] * inv); w0.y = pk2(o0[4 * r4 + 2] * inv, o0[4 * r4 + 3] * inv);
                v2u w1; w1.x = pk2(o1[4 * r4] * inv, o1[4 * r4 + 1] * inv); w1.y = pk2(o1[4 * r4 + 2] * inv, o1[4 * r4 + 3] * inv);
                *(v2u*)(op + (r4 >> 1) * 1024 + (r4 & 1) * 512) = w0; *(v2u*)(op + 2048 + (r4 >> 1) * 1024 + (r4 & 1) * 512) = w1; }
            if (hi == 0) { const size_t tok = (size_t)(bh >> 3) * SEQ + (size_t)((32 * n + q) << sh) + r; LSE[tok * 8 + (bh & 7)] = m + __builtin_amdgcn_logf(l); }
            m = -3.0e38f; l = 0.f; o0 = (f32x16){}; o1 = (f32x16){};
#pragma unroll
            for (int x = 0; x < 4; ++x) qf[x] = qn[x];
        }
    }
#undef ATT_LOADKV
}

__device__ __forceinline__ void p3_attention(Frame& F, bool dummy) {
    const int gw = F.vcu * NWAVES + F.wave;
    char* ACT = (char*)(F.ws + WS_ACT); float* LSE = dummy ? (float*)(F.ws + 12 * MiB) : (float*)(F.ws + WS_LSE);
    LAS float* tbl = (LAS float*)(F.lds + RING_OFF + ATT_TBL);
    { const float* BD = (const float*)(F.ws + WS_BT);
      for (int e = F.tid; e < 25 * 192; e += NWAVES * 64) { const int gh = e / 192, dist = 159 - (e % 192);
          tbl[e] = (gh < 24 && dist >= 0 && dist <= 128) ? BD[gh * 129 + dist] : NEG_BIG; }
      LDS_WAIT(); __syncthreads(); }
    for (int g = 0; g < 3; ++g) {
        char* Qg = ACT + (size_t)(g * 3) * ABYTES;
        attn_chain(F.lane, g, gw, Qg, Qg + ABYTES, Qg + 2 * ABYTES, LSE + (size_t)g * NTOK * 8, tbl, dummy, (char*)(F.ws + WS_DUMMY));
    }
    __syncthreads();
}
template <int G> __device__ __forceinline__ void poolmix_item(int lane, int T, const bf16* UT, bf16* ZP, bf16* DST, const bf16* PWF, const float* pscale) {
    constexpr int W = 2 << G;
    const int q = lane & 31, hi = lane >> 5, tok = T * 32 + q, t = tok & (SEQ - 1);
    f32x16 acc[4] = {};
#pragma unroll 2
    for (int ks = 0; ks < 8; ++ks) {
        const int c8 = G * 16 + 2 * ks + hi;
        const bf16* up = UT + ((size_t)c8 * NTOK + tok) * 8;
        v4u vv[W];
#pragma unroll
        for (int j = 0; j < W; ++j) vv[j] = *(const v4u*)(up - (j <= t ? j : 0) * 8);
        float sm[8];
#pragma unroll
        for (int e = 0; e < 8; ++e) sm[e] = 0.f;
#pragma unroll
        for (int j = 1; j < W; ++j) { const float wt = j <= t ? 1.f : 0.f; const v4u v = vv[j];
            sm[0] += wt * bf_lo(v.x); sm[1] += wt * bf_hi(v.x); sm[2] += wt * bf_lo(v.y); sm[3] += wt * bf_hi(v.y); sm[4] += wt * bf_lo(v.z); sm[5] += wt * bf_hi(v.z); sm[6] += wt * bf_lo(v.w); sm[7] += wt * bf_hi(v.w); }
        const float ic = 1.f / (float)((t + 1) < W ? (t + 1) : W), c0 = ic - 1.f; const v4u v0 = vv[0];
        v4u pw; pw.x = pk2(sm[0] * ic + c0 * bf_lo(v0.x), sm[1] * ic + c0 * bf_hi(v0.x)); pw.y = pk2(sm[2] * ic + c0 * bf_lo(v0.y), sm[3] * ic + c0 * bf_hi(v0.y));
        pw.z = pk2(sm[4] * ic + c0 * bf_lo(v0.z), sm[5] * ic + c0 * bf_hi(v0.z)); pw.w = pk2(sm[6] * ic + c0 * bf_lo(v0.w), sm[7] * ic + c0 * bf_hi(v0.w));
        const bf16x8 bfrag = __builtin_bit_cast(bf16x8, pw);
#pragma unroll
        for (int et = 0; et < 4; ++et) { const bf16x8 af = *(const bf16x8*)(PWF + ((size_t)((G * 4 + et) * 8 + ks) * 64 + lane) * 8);
            acc[et] = __builtin_amdgcn_mfma_f32_32x32x16_bf16(af, bfrag, acc[et], 0, 0, 0); }
    }
#pragma unroll
    for (int et = 0; et < 4; ++et)
#pragma unroll
        for (int r4 = 0; r4 < 4; ++r4) { const int col = G * 128 + et * 32 + 8 * r4 + 4 * hi; const size_t off = ((size_t)(col >> 3) * NTOK + tok) * 8 + 4 * hi;
            const v2u z = *(const v2u*)(ZP + off); const f32x4 ps = *(const f32x4*)(pscale + col);
            v2u w; w.x = pk2(acc[et][4 * r4] * ps.x * bf_lo(z.x), acc[et][4 * r4 + 1] * ps.y * bf_hi(z.x)); w.y = pk2(acc[et][4 * r4 + 2] * ps.z * bf_lo(z.y), acc[et][4 * r4 + 3] * ps.w * bf_hi(z.y));
            *(v2u*)(DST + off) = w; }
}
__device__ __forceinline__ void p3_poolmix(Frame& F, const float* pscale, bool dummy) {
    const int gw = F.vcu * NWAVES + F.wave, NGW = F.G * NWAVES;
    bf16* ACT = (bf16*)(F.ws + WS_ACT); const bf16* UT = ACT + 11 * pg8::ABUF; bf16* ZP = ACT + 10 * pg8::ABUF; const bf16* PWF = (const bf16*)(F.ws + WS_PWBD);
    bf16* DST = dummy ? (bf16*)(F.ws + WS_H) : ZP;
    for (int it = gw; it < 4096; it += NGW) { const int g = it >> 10, T = it & 1023;
        if (g == 0) poolmix_item<0>(F.lane, T, UT, ZP, DST, PWF, pscale);
        else if (g == 1) poolmix_item<1>(F.lane, T, UT, ZP, DST, PWF, pscale);
        else if (g == 2) poolmix_item<2>(F.lane, T, UT, ZP, DST, PWF, pscale);
        else poolmix_item<3>(F.lane, T, UT, ZP, DST, PWF, pscale); }
}
__device__ __forceinline__ void p4_combine(Frame& F, bool dummy) {
    const int gw = F.vcu * NWAVES + F.wave, NGW = F.G * NWAVES;
    const char* ACT = (const char*)(F.ws + WS_ACT); const float* LSE = (const float*)(F.ws + WS_LSE);
    const char* O0 = ACT; const char* O1 = ACT + 3 * ABYTES; const char* O2 = ACT + 6 * ABYTES; bf16* ZA = (bf16*)(F.ws + WS_ACT + 9 * ABYTES);
    bf16* DST = dummy ? (bf16*)(F.ws + WS_DUMMY) : ZA;
    const int q = F.lane & 31, hp = F.lane >> 5;
    for (int it = gw; it < 64 * 128 * 4; it += NGW) { const int dk = it & 3, lt0 = (it >> 2) & 127, bh = it >> 9, b = bh >> 3, h = bh & 7;
        const int tt = 32 * lt0 + q; const size_t tok = (size_t)b * SEQ + tt; const int inb = dk * 1024 + hp * 512;
        const float l0 = LSE[tok * 8 + h], l1 = LSE[((size_t)NTOK + tok) * 8 + h], l2 = LSE[((size_t)2 * NTOK + tok) * 8 + h];
        const v4u a = *(const v4u*)(O0 + ((size_t)(bh * 128 + lt0) << 12) + inb + q * 16);
        const v4u bb = *(const v4u*)(O1 + ((size_t)(bh * 128 + (tt & 3) * 32 + (tt >> 7)) << 12) + inb + ((tt >> 2) & 31) * 16);
        const v4u cc = *(const v4u*)(O2 + ((size_t)(bh * 128 + (tt & 15) * 8 + (tt >> 9)) << 12) + inb + ((tt >> 4) & 31) * 16);
        const size_t off = ((size_t)(h * 8 + dk * 2 + hp) * NTOK + tok) * 8;
        const v4u z = *(const v4u*)(ZA + off);
        const float mx = fmaxf(l0, fmaxf(l1, l2)); float w0 = __builtin_amdgcn_exp2f(l0 - mx), w1 = __builtin_amdgcn_exp2f(l1 - mx), w2 = __builtin_amdgcn_exp2f(l2 - mx);
        const float inv = 1.f / (w0 + w1 + w2); w0 *= inv; w1 *= inv; w2 *= inv;
        v4u o;
        o.x = pk2((w0 * bf_lo(a.x) + w1 * bf_lo(bb.x) + w2 * bf_lo(cc.x)) * bf_lo(z.x), (w0 * bf_hi(a.x) + w1 * bf_hi(bb.x) + w2 * bf_hi(cc.x)) * bf_hi(z.x));
        o.y = pk2((w0 * bf_lo(a.y) + w1 * bf_lo(bb.y) + w2 * bf_lo(cc.y)) * bf_lo(z.y), (w0 * bf_hi(a.y) + w1 * bf_hi(bb.y) + w2 * bf_hi(cc.y)) * bf_hi(z.y));
        o.z = pk2((w0 * bf_lo(a.z) + w1 * bf_lo(bb.z) + w2 * bf_lo(cc.z)) * bf_lo(z.z), (w0 * bf_hi(a.z) + w1 * bf_hi(bb.z) + w2 * bf_hi(cc.z)) * bf_hi(z.z));
        o.w = pk2((w0 * bf_lo(a.w) + w1 * bf_lo(bb.w) + w2 * bf_lo(cc.w)) * bf_lo(z.w), (w0 * bf_hi(a.w) + w1 * bf_hi(bb.w) + w2 * bf_hi(cc.w)) * bf_hi(z.w));
        *(GAS v4u*)(DST + off) = o; }
}
__device__ __forceinline__ void p7_final_norm(Frame& F, const float* final_g, float* out, float* dst) {
    const int gw = F.vcu * NWAVES + F.wave, NGW = F.G * NWAVES;
    const float* RS = (const float*)(F.ws + WS_ROWSQ);
    f32x4 gv[4];
#pragma unroll
    for (int j = 0; j < 4; ++j) gv[j] = ((const f32x4*)final_g)[F.lane + 64 * j];
    for (int row0 = gw * 4; row0 < NTOK; row0 += NGW * 4) {
        f32x4 v[4][4]; float s[4];
#pragma unroll
        for (int rr = 0; rr < 4; ++rr) { s[rr] = (F.lane < 16) ? RS[(size_t)(row0 + rr) * 16 + F.lane] : 0.f;
            const GAS f32x4* xr = (const GAS f32x4*)(out + (size_t)(row0 + rr) * 1024) + F.lane;
#pragma unroll
            for (int j = 0; j < 4; ++j) v[rr][j] = xr[64 * j]; }
#pragma unroll
        for (int o = 1; o < 16; o <<= 1) {
#pragma unroll
            for (int rr = 0; rr < 4; ++rr) s[rr] += __shfl_xor(s[rr], o); }
#pragma unroll
        for (int rr = 0; rr < 4; ++rr) { const float rstd = 1.f / sqrtf(__shfl(s[rr], 0) * (1.f / 1024.f) + EPS);
            GAS f32x4* dr = (GAS f32x4*)(dst + (size_t)(row0 + rr) * 1024) + F.lane;
#pragma unroll
            for (int j = 0; j < 4; ++j) dr[64 * j] = v[rr][j] * rstd * gv[j]; } }
}

struct Args { const float* in[13]; float* out; unsigned char* ws; int ph_lo, ph_hi, li, pad; };
__global__ void __launch_bounds__(NWAVES * 64, 2) mixer_fwd(Args args) {
    extern __shared__ __attribute__((aligned(16))) unsigned char lds[];
    Frame F;
    F.lds = (LAS unsigned char*)lds;
    F.MISC = (volatile LAS unsigned*)(F.lds + MISC_OFF);
    F.tid = threadIdx.x; F.lane = F.tid & 63; F.wave = __builtin_amdgcn_readfirstlane(F.tid >> 6);
    F.G = gridDim.x; { const int bx = blockIdx.x; F.vcu = (F.G % 8 == 0) ? (bx % 8) * (F.G / 8) + bx / 8 : bx; }
    F.ws = args.ws; F.ctl = (gu32*)(args.ws + WS_CTL);
    for (int u = F.tid; u < (LDS_BYTES - LDSCTL_OFF) / 4; u += NWAVES * 64) ((LAS unsigned*)(F.lds + LDSCTL_OFF))[u] = 0u;
    __syncthreads();
    XcdBarrier bar; bar.bar = (unsigned*)(F.ctl + CW_BAR); bar.x = 0; bar.st = nullptr;
    if (N_LAUNCHES == 1) bar = xcd_barrier_post((unsigned*)(F.ctl + CW_BAR), F.MISC + 8);
#define GRID_BAR() do { if (N_LAUNCHES == 1) xcd_barrier(bar); } while (0)
    const int lo = args.ph_lo, hi = args.ph_hi;
#define IN(k) (lo <= (k) && (k) < hi)
#define BOTH(k) (IN(k) && IN((k) + 1))
    bf16* ACT = (bf16*)(F.ws + WS_ACT);
    const int G = F.G, bid = (int)blockIdx.x;

    const bool dm = args.pad != 0;
    if (IN(0)) { p0_prologue(F, args.in); if (BOTH(0)) GRID_BAR(); }
    if (IN(1)) { p1_hrows(F, args.in); if (BOTH(1)) GRID_BAR(); }
    if (IN(2)) {
        { pg8::Gemm g{(const bf16*)(F.ws + WS_H), (const bf16*)(F.ws + WS_WMAIN), NTOK, NMAIN, 1024}; pg8::StaticOrder S; S.init(NTOK, NMAIN, G, bid);
          pg8::EpiProj E{ACT, (bf16*)args.out};
          pg8::gemm_phase<pg8::EpiProj, pg8::StaticOrder, true, true, 0>(F.lds + RING_OFF, g, S, E); }
        { pg8::Gemm g{(const bf16*)(F.ws + WS_WV), (const bf16*)(F.ws + WS_H), 512, NTOK, 1024}; pg8::StaticOrder S; S.init(512, NTOK, G, bid);
          pg8::EpiVT<1> E{ACT + 2 * pg8::ABUF};
          pg8::gemm_phase<pg8::EpiVT<1>, pg8::StaticOrder, false, true, 1>(F.lds + RING_OFF, g, S, E); }
        { pg8::Gemm g{(const bf16*)(F.ws + WS_WV) + (size_t)512 * 1024, (const bf16*)(F.ws + WS_H), 512, NTOK, 1024}; pg8::StaticOrder S; S.init(512, NTOK, G, bid);
          pg8::EpiVT<4> E{ACT + 5 * pg8::ABUF};
          pg8::gemm_phase<pg8::EpiVT<4>, pg8::StaticOrder, false, true, 4>(F.lds + RING_OFF, g, S, E); }
        { pg8::Gemm g{(const bf16*)(F.ws + WS_WV) + (size_t)1024 * 1024, (const bf16*)(F.ws + WS_H), 512, NTOK, 1024}; pg8::StaticOrder S; S.init(512, NTOK, G, bid);
          pg8::EpiVT<16> E{ACT + 8 * pg8::ABUF};
          pg8::gemm_phase<pg8::EpiVT<16>, pg8::StaticOrder, false, true, 16>(F.lds + RING_OFF, g, S, E); }
        if (BOTH(2)) GRID_BAR();
    }
    if (IN(3)) { if (!(dm && PROBE_SUB == 2)) p3_attention(F, dm); if (!(dm && PROBE_SUB == 1)) p3_poolmix(F, args.in[7], dm); if (BOTH(3)) GRID_BAR(); }
    if (IN(4)) {
        p4_combine(F, dm);
        if (BOTH(4)) GRID_BAR();
    }
    if (IN(5)) {
        { pg8::Gemm g{ACT + 9 * pg8::ABUF, (const bf16*)(F.ws + WS_WATT), NTOK, 1024, 512}; pg8::StaticOrder S; S.init(NTOK, 1024, G, bid);
          pg8::EpiGate<true> E{(const bf16*)args.out, nullptr, (bf16*)(F.ws + WS_PART)};
          pg8::gemm_phase<pg8::EpiGate<true>, pg8::StaticOrder, true, true, 0, 1>(F.lds + RING_OFF, g, S, E); }
        { pg8::Gemm g{ACT + 10 * pg8::ABUF, (const bf16*)(F.ws + WS_WPOOL), NTOK, 1024, 512}; pg8::StaticOrder S; S.init(NTOK, 1024, G, bid);
          pg8::EpiGate<false> E{(const bf16*)args.out + (size_t)NTOK * 1024, (const bf16*)(F.ws + WS_PART), (bf16*)(F.ws + WS_MG)};
          pg8::gemm_phase<pg8::EpiGate<false>, pg8::StaticOrder, true, true, 0, 1>(F.lds + RING_OFF, g, S, E); }
        if (BOTH(5)) GRID_BAR();
    }
    if (IN(6)) {
        { pg8::Gemm g{(const bf16*)(F.ws + WS_MG), (const bf16*)(F.ws + WS_WOUT), NTOK, 1024, 1024}; pg8::StaticOrder S; S.init(NTOK, 1024, G, bid);
          pg8::EpiFinal E{args.in[0], args.out, (const float*)(F.ws + WS_MOD), (float*)(F.ws + WS_ROWSQ)};
          pg8::gemm_phase<pg8::EpiFinal, pg8::StaticOrder, true, true, 0>(F.lds + RING_OFF, g, S, E); }
        if (BOTH(6)) GRID_BAR();
    }
    if (IN(7)) { p7_final_norm(F, args.in[12], args.out, dm ? (float*)(F.ws + WS_ACT) : args.out); }
#undef IN
#undef BOTH
}

extern "C" void kernel_launch(void* const* d_in, const int* in_sizes, int n_in, void* d_out, int out_size, void* d_ws, size_t ws_size, hipStream_t stream) {
    static int grid = 0;
    if (grid == 0) {
        if (n_in != 13 || in_sizes[0] != NTOK * DM || out_size != NTOK * DM || ws_size < WS_END) { fprintf(stderr, "kernel_launch: unexpected shapes (n_in %d, in0 %d, out %d, ws %zu); nothing launched\n", n_in, n_in > 0 ? in_sizes[0] : -1, out_size, ws_size); grid = -1; return; }
        int dev = 0, cus = 0, per_cu = 0;
        if (hipGetDevice(&dev) != hipSuccess || hipDeviceGetAttribute(&cus, hipDeviceAttributeMultiprocessorCount, dev) != hipSuccess) { grid = -1; return; }
        if (hipFuncSetAttribute((const void*)mixer_fwd, hipFuncAttributeMaxDynamicSharedMemorySize, LDS_BYTES) != hipSuccess) { fprintf(stderr, "kernel_launch: hipFuncSetAttribute failed\n"); grid = -1; return; }
        if (hipOccupancyMaxActiveBlocksPerMultiprocessor(&per_cu, (const void*)mixer_fwd, NWAVES * 64, LDS_BYTES) != hipSuccess || per_cu < 1) { fprintf(stderr, "kernel_launch: occupancy query says %d blocks per CU\n", per_cu); (void)hipGetLastError(); grid = -1; return; }
        grid = cus;
        if (grid != 256) { fprintf(stderr, "kernel_launch: built for 256 CUs, device has %d\n", cus); grid = -1; return; }
    }
    if (grid < 0) return;
    if (hipMemsetAsync((char*)d_ws + WS_CTL, 0, CTL_ZERO_BYTES, stream) != hipSuccess) return;
    Args a{};
    for (int i = 0; i < 13; ++i) a.in[i] = (const float*)d_in[i];
    a.out = (float*)d_out; a.ws = (unsigned char*)d_ws;
    if (N_LAUNCHES == 1) {
        a.ph_lo = 0; a.ph_hi = NPHASE; a.li = 0;
        void* kargs[] = {&a};
        hipError_t e = hipLaunchCooperativeKernel((const void*)mixer_fwd, dim3(grid), dim3(NWAVES * 64), kargs, LDS_BYTES, stream);
        if (e != hipSuccess) fprintf(stderr, "kernel_launch: cooperative launch failed: %s\n", hipGetErrorString(e));
    } else {
        for (int li = 0; li < NPHASE; ++li) { a.ph_lo = li; a.ph_hi = li + 1; a.li = li;
            for (int rep = (PROBE_DUP >> li) & 1; rep >= 0; --rep) { a.pad = rep;
                hipLaunchKernelGGL(mixer_fwd, dim3(grid), dim3(NWAVES * 64), LDS_BYTES, stream, a); } }
    }
}
```

```cpp
#include <hip/hip_runtime.h>
#include <cstdio>
#include <cstdint>

#ifndef PROBE_DUP
#define PROBE_DUP 0
#endif
#ifndef PROBE_SUB
#define PROBE_SUB 1
#endif
#ifndef MK_N_LAUNCHES
#define MK_N_LAUNCHES 1
#endif

constexpr int BATCH = 8, SEQ = 4096, DM = 1024, NTOK = BATCH * SEQ;
constexpr int INW = 8192, NMAIN = 6656, NVT = 1536;
constexpr float EPS = 1e-6f;
constexpr float LOG2E = 1.4426950408889634f;
constexpr float QSCALE = 0.125f * LOG2E;
constexpr float NEG_BIG = -1e30f;

namespace pg8 {
#define PG8_LAS __attribute__((address_space(3)))
typedef unsigned short bf16_t;
typedef short bf16x8 __attribute__((ext_vector_type(8)));
typedef float f32x4 __attribute__((ext_vector_type(4)));
typedef unsigned u32x4 __attribute__((ext_vector_type(4)));
constexpr int BM = 256, BK = 64, HALF = 128, HTB = HALF * BK * 2, STAGE_BYTES = 8 * HTB, NXCD = 8, WGM = 8;

__host__ __device__ __forceinline__ int lds_byte(int r, int c) { const int st = (r >> 4) * 2 + (c >> 5), rr = r & 15, cc = c & 31, ob = rr * 64 + cc * 2; return st * 1024 + (ob ^ (((ob >> 9) & 1) << 5)); }
__host__ __device__ __forceinline__ void stage_rc(int b, int& R, int& C) { const int st = b / 1024, sb = b % 1024, swz = sb ^ (((sb >> 9) & 1) << 5); R = (st >> 1) * 16 + swz / 64; C = (st & 1) * 32 + (swz % 64) / 2; }
__host__ __device__ __forceinline__ int perm32(int rho) { const int n = rho >> 4, i = rho & 15; return 8 * (i >> 2) + 4 * n + (i & 3); }
__host__ __device__ __forceinline__ int tau16(int k) { return ((k & 4) << 1) | ((k & 8) >> 1) | (k & 3); }
template <int BMODE> __host__ __device__ __forceinline__ int bmap(int Rb) {
    if (BMODE == 1) return 16 * (Rb >> 4) + tau16(Rb & 15);
    if (BMODE == 4) { const int blkh = Rb >> 4, lbl = blkh >> 2, r = blkh & 3; return (16 * lbl + tau16(Rb & 15)) * 4 + r; }
    if (BMODE == 16) return tau16(Rb & 15) * 16 + (Rb >> 4);
    return Rb;
}

struct Unit { int pm, pn; };
struct Gemm { const bf16_t* A; const bf16_t* Bt; int M, N, K; };

struct StaticOrder {
    int nM, nN, nwg, G, c;
    __host__ __device__ void init(int M, int N, int G_, int c_) { nM = M / BM; nN = N / BM; nwg = nM * nN; G = G_; c = c_; }
    __host__ __device__ bool next(int i, Unit& u) const {
        const long L = (long)i * G + c; if (L >= nwg) return false;
        int wgid = (int)L; { const int q = nwg / NXCD, r = nwg % NXCD, xcd = wgid % NXCD, off = wgid / NXCD; wgid = (xcd < r ? xcd * (q + 1) : r * (q + 1) + (xcd - r) * q) + off; }
        const int nig = WGM * nN, gid = wgid / nig, fm = gid * WGM, gsz = (nM - fm) < WGM ? (nM - fm) : WGM;
        u.pm = fm + ((wgid % nig) % gsz); u.pn = (wgid % nig) / gsz; return true;
    }
    __device__ __forceinline__ void a_ready(const Unit&) const {}
    __device__ __forceinline__ void done(const Unit&) const {}
};

__device__ __forceinline__ unsigned cvt_pk_bf16(float lo, float hi) { unsigned r; asm volatile("s_nop 1\n\tv_cvt_pk_bf16_f32 %0, %1, %2" : "=v"(r) : "v"(lo), "v"(hi)); return r; }
__device__ __forceinline__ float bf_lo(unsigned w) { return __uint_as_float(w << 16); }
__device__ __forceinline__ float bf_hi(unsigned w) { return __uint_as_float(w & 0xffff0000u); }
__device__ __forceinline__ float sigm(float v) { return __builtin_amdgcn_rcpf(1.f + __builtin_amdgcn_exp2f(-LOG2E * v)); }


constexpr size_t ABUF = (size_t)NTOK * 512;
struct EpiProj {
    static constexpr bool PERM = true, AFTER_DRAIN = false; static constexpr int MIDK = 0;
    bf16_t* act; bf16_t* sg;
    __device__ __forceinline__ void operator()(const f32x4 (&acc)[2][2][4][2], const Unit& u, int wr, int wc, int fr, int fq) const {
        const int pn = u.pn;
        if (pn < 12) {
            const int g = pn >> 2, type = (pn >> 1) & 1, sh = 2 * g, NB = 128 >> sh; char* base = (char*)(act + (size_t)(g * 3 + type) * ABUF);
            const float sc = type == 0 ? QSCALE : 1.f;
            const int b = u.pm >> 4, tt0 = (u.pm & 15) * 256 + wr * 64 + fr;
            const int dkhi = ((wc & 1) * 2 + (fq >> 1)) * 1024 + (fq & 1) * 512;
#pragma unroll
            for (int ai = 0; ai < 2; ++ai)
#pragma unroll
                for (int m = 0; m < 4; ++m) { const int tt = tt0 + ai * HALF + m * 16, r = tt & ((1 << sh) - 1), l = tt >> sh;
                    const int blk0 = (b * 8) * 128 + r * NB + (l >> 5); const int inb = dkhi + (l & 31) * 16;
#pragma unroll
                    for (int bj = 0; bj < 2; ++bj) { const int h = (pn & 1) * 4 + bj * 2 + (wc >> 1);
                        const f32x4 v0 = acc[ai][bj][m][0] * sc, v1 = acc[ai][bj][m][1] * sc;
                        u32x4 w; w.x = cvt_pk_bf16(v0[0], v0[1]); w.y = cvt_pk_bf16(v0[2], v0[3]); w.z = cvt_pk_bf16(v1[0], v1[1]); w.w = cvt_pk_bf16(v1[2], v1[3]);
                        *(u32x4*)(base + ((size_t)(blk0 + h * 128) << 12) + inb) = w; } }
            return;
        }
        if (pn < 18) {
            const int j = (pn - 12) >> 1; bf16_t* base = act + (size_t)9 * ABUF + (j == 1 ? 2 * ABUF : (j == 2 ? ABUF : 0));
            const int row0 = u.pm * BM + wr * 64 + fr;
#pragma unroll
            for (int ai = 0; ai < 2; ++ai)
#pragma unroll
                for (int m = 0; m < 4; ++m) { const int tok = row0 + ai * HALF + m * 16;
#pragma unroll
                    for (int bj = 0; bj < 2; ++bj) { const int c8 = (pn & 1) * 32 + bj * 16 + wc * 4 + fq; f32x4 v0 = acc[ai][bj][m][0], v1 = acc[ai][bj][m][1];
                        if (j != 1) {
#pragma unroll
                            for (int e = 0; e < 4; ++e) { v0[e] = v0[e] * sigm(v0[e]); v1[e] = v1[e] * sigm(v1[e]); } }
                        u32x4 w; w.x = cvt_pk_bf16(v0[0], v0[1]); w.y = cvt_pk_bf16(v0[2], v0[3]); w.z = cvt_pk_bf16(v1[0], v1[1]); w.w = cvt_pk_bf16(v1[2], v1[3]);
                        *(u32x4*)(base + ((size_t)c8 * NTOK + tok) * 8) = w; } }
            return;
        }
        bf16_t* base; int ldc, colt, mode;
        { const int j = (pn - 18) >> 2; base = sg + (size_t)j * ((size_t)NTOK * 1024); ldc = 1024; colt = ((pn - 18) & 3) * 256; mode = 3; }
        const int row0 = u.pm * BM + wr * 64 + fr, col0 = colt + wc * 32 + 8 * fq;
#pragma unroll
        for (int ai = 0; ai < 2; ++ai)
#pragma unroll
            for (int m = 0; m < 4; ++m) { bf16_t* rowp = base + (size_t)(row0 + ai * HALF + m * 16) * ldc + col0;
#pragma unroll
                for (int bj = 0; bj < 2; ++bj) { f32x4 v0 = acc[ai][bj][m][0], v1 = acc[ai][bj][m][1];
                    if (mode == 2) {
#pragma unroll
                        for (int e = 0; e < 4; ++e) { v0[e] = v0[e] * sigm(v0[e]); v1[e] = v1[e] * sigm(v1[e]); } }
                    else if (mode == 3) {
#pragma unroll
                        for (int e = 0; e < 4; ++e) { v0[e] = sigm(v0[e]); v1[e] = sigm(v1[e]); } }
                    u32x4 w; w.x = cvt_pk_bf16(v0[0], v0[1]); w.y = cvt_pk_bf16(v0[2], v0[3]); w.z = cvt_pk_bf16(v1[0], v1[1]); w.w = cvt_pk_bf16(v1[2], v1[3]);
                    *(u32x4*)(rowp + bj * HALF) = w; } }
    }
};
template <int DIL> struct EpiVT {
    static constexpr bool PERM = true, AFTER_DRAIN = false; static constexpr int MIDK = 0;
    bf16_t* VT;
    __device__ __forceinline__ void operator()(const f32x4 (&acc)[2][2][4][2], const Unit& u, int wr, int wc, int fr, int fq) const {
        const int pn = u.pn, b = pn >> 4;
#pragma unroll
        for (int bj = 0; bj < 2; ++bj) {
            const int blk = bj * 8 + wc * 2 + (fq >> 1), h16 = fq & 1; int vb;
            if (DIL == 1) vb = 16 * (pn & 15) + blk;
            else if (DIL == 4) { const int lbl = blk >> 2, r = blk & 3; vb = r * 64 + 4 * (pn & 15) + lbl; }
            else vb = blk * 16 + (pn & 15);
#pragma unroll
            for (int ai = 0; ai < 2; ++ai) { const int h = u.pm * 4 + ai * 2 + wr;
                bf16_t* bp = VT + ((size_t)((b * 8 + h) * 256 + vb) << 10) + h16 * 8;
#pragma unroll
                for (int m = 0; m < 4; ++m) { const int d = m * 16 + fr;
                    const f32x4 v0 = acc[ai][bj][m][0], v1 = acc[ai][bj][m][1];
                    u32x4 w; w.x = cvt_pk_bf16(v0[0], v0[1]); w.y = cvt_pk_bf16(v0[2], v0[3]); w.z = cvt_pk_bf16(v1[0], v1[1]); w.w = cvt_pk_bf16(v1[2], v1[3]);
                    *(u32x4*)(bp + d * 16) = w; } }
        }
    }
};
struct EpiMix {
    static constexpr bool PERM = true, AFTER_DRAIN = false; static constexpr int MIDK = 0;
    bf16_t* ZP; const float* pscale; bf16_t* DST;
    __device__ __forceinline__ void operator()(const f32x4 (&acc)[2][2][4][2], const Unit& u, int wr, int wc, int fr, int fq) const {
        const int row0 = u.pm * BM + wr * 64 + fr, col0 = u.pn * BM + wc * 32 + 8 * fq;
        f32x4 sv[2][2];
#pragma unroll
        for (int bj = 0; bj < 2; ++bj)
#pragma unroll
            for (int n = 0; n < 2; ++n) sv[bj][n] = *(const f32x4*)(pscale + col0 + bj * HALF + 4 * n);
#pragma unroll
        for (int ai = 0; ai < 2; ++ai)
#pragma unroll
            for (int m = 0; m < 4; ++m) { bf16_t* rowp = ZP + (size_t)(row0 + ai * HALF + m * 16) * 512 + col0;
#pragma unroll
                for (int bj = 0; bj < 2; ++bj) { const u32x4 z = *(const u32x4*)(rowp + bj * HALF);
                    const f32x4 v0 = acc[ai][bj][m][0] * sv[bj][0], v1 = acc[ai][bj][m][1] * sv[bj][1];
                    u32x4 w; w.x = cvt_pk_bf16(v0[0] * bf_lo(z.x), v0[1] * bf_hi(z.x)); w.y = cvt_pk_bf16(v0[2] * bf_lo(z.y), v0[3] * bf_hi(z.y));
                    w.z = cvt_pk_bf16(v1[0] * bf_lo(z.z), v1[1] * bf_hi(z.z)); w.w = cvt_pk_bf16(v1[2] * bf_lo(z.w), v1[3] * bf_hi(z.w));
                    *(u32x4*)(DST + (rowp - ZP) + bj * HALF) = w; } }
    }
};
struct EpiMerge {
    static constexpr bool PERM = true, AFTER_DRAIN = false; static constexpr int MIDK = 8;
    const bf16_t* sga; const bf16_t* sgp; bf16_t* out;
    static __device__ __forceinline__ float clampg(float v) { return fmaxf(v, 1e-30f); }
    __device__ __forceinline__ void mid(f32x4 (&acc)[2][2][4][2], const Unit& u, int wr, int wc, int fr, int fq) const {
        int row0 = u.pm * BM + wr * 64 + fr, col0 = u.pn * BM + wc * 32 + 8 * fq;
        asm volatile("" : "+v"(row0), "+v"(col0));
#pragma unroll
        for (int ai = 0; ai < 2; ++ai)
#pragma unroll
            for (int m = 0; m < 4; ++m) { const size_t off = (size_t)(row0 + ai * HALF + m * 16) * 1024 + col0;
#pragma unroll
                for (int bj = 0; bj < 2; ++bj) { const u32x4 ga = *(const u32x4*)(sga + off + bj * HALF), gp = *(const u32x4*)(sgp + off + bj * HALF);
                    f32x4& a0 = acc[ai][bj][m][0]; f32x4& a1 = acc[ai][bj][m][1];
                    a0[0] *= bf_lo(ga.x) * __builtin_amdgcn_rcpf(clampg(bf_lo(gp.x))); a0[1] *= bf_hi(ga.x) * __builtin_amdgcn_rcpf(clampg(bf_hi(gp.x)));
                    a0[2] *= bf_lo(ga.y) * __builtin_amdgcn_rcpf(clampg(bf_lo(gp.y))); a0[3] *= bf_hi(ga.y) * __builtin_amdgcn_rcpf(clampg(bf_hi(gp.y)));
                    a1[0] *= bf_lo(ga.z) * __builtin_amdgcn_rcpf(clampg(bf_lo(gp.z))); a1[1] *= bf_hi(ga.z) * __builtin_amdgcn_rcpf(clampg(bf_hi(gp.z)));
                    a1[2] *= bf_lo(ga.w) * __builtin_amdgcn_rcpf(clampg(bf_lo(gp.w))); a1[3] *= bf_hi(ga.w) * __builtin_amdgcn_rcpf(clampg(bf_hi(gp.w))); }
                asm volatile("" ::: "memory"); }
    }
    __device__ __forceinline__ void operator()(const f32x4 (&acc)[2][2][4][2], const Unit& u, int wr, int wc, int fr, int fq) const {
        const int row0 = u.pm * BM + wr * 64 + fr, col0 = u.pn * BM + wc * 32 + 8 * fq;
#pragma unroll
        for (int ai = 0; ai < 2; ++ai)
#pragma unroll
            for (int m = 0; m < 4; ++m) { const size_t off = (size_t)(row0 + ai * HALF + m * 16) * 1024 + col0;
#pragma unroll
                for (int bj = 0; bj < 2; ++bj) { const u32x4 gp = *(const u32x4*)(sgp + off + bj * HALF);
                    const f32x4 a0 = acc[ai][bj][m][0], a1 = acc[ai][bj][m][1];
                    u32x4 w; w.x = cvt_pk_bf16(a0[0] * clampg(bf_lo(gp.x)), a0[1] * clampg(bf_hi(gp.x))); w.y = cvt_pk_bf16(a0[2] * clampg(bf_lo(gp.y)), a0[3] * clampg(bf_hi(gp.y)));
                    w.z = cvt_pk_bf16(a1[0] * clampg(bf_lo(gp.z)), a1[1] * clampg(bf_hi(gp.z))); w.w = cvt_pk_bf16(a1[2] * clampg(bf_lo(gp.w)), a1[3] * clampg(bf_hi(gp.w)));
                    *(u32x4*)(out + off + bj * HALF) = w; } }
    }
};
struct EpiFinal {
    static constexpr bool PERM = false, AFTER_DRAIN = false; static constexpr int MIDK = 0;
    const float* x; float* out; const float* gate; float* rowsq;
    __device__ __forceinline__ void operator()(const f32x4 (&acc)[2][2][4][2], const Unit& u, int wr, int wc, int fr, int fq) const {
        const int row0 = u.pm * BM + wr * 64 + fr, col0 = u.pn * BM + wc * 32 + 4 * fq;
        const float* gp = gate + (size_t)((u.pm * BM) / SEQ) * 1024 + col0;
        f32x4 gv[2][2];
#pragma unroll
        for (int bj = 0; bj < 2; ++bj)
#pragma unroll
            for (int n = 0; n < 2; ++n) gv[bj][n] = *(const f32x4*)(gp + bj * HALF + n * 16);
#pragma unroll
        for (int ai = 0; ai < 2; ++ai)
#pragma unroll
            for (int m = 0; m < 4; ++m) { const int row = row0 + ai * HALF + m * 16; const size_t off = (size_t)row * 1024 + col0; float sq = 0.f;
#pragma unroll
                for (int bj = 0; bj < 2; ++bj)
#pragma unroll
                    for (int n = 0; n < 2; ++n) { const f32x4 xv = *(const f32x4*)(x + off + bj * HALF + n * 16); const f32x4 o = xv + gv[bj][n] * acc[ai][bj][m][n];
                        sq += (o[0] * o[0] + o[1] * o[1]) + (o[2] * o[2] + o[3] * o[3]); *(f32x4*)(out + off + bj * HALF + n * 16) = o; }
                sq += __shfl_xor(sq, 16); sq += __shfl_xor(sq, 32);
                if (fq == 0) rowsq[(size_t)row * 16 + u.pn * 4 + wc] = sq; }
    }
};

template <class Epi, class Sched, bool ALIGN_EPI = false, bool SP2 = false, int BMODE = 0, int AMODE = 0>
__device__ __forceinline__ void gemm_phase(PG8_LAS unsigned char* lds, const Gemm g, const Sched& S, const Epi& E) {
    const int tid = threadIdx.x, wid = __builtin_amdgcn_readfirstlane(tid >> 6), lane = tid & 63, wr = wid >> 2, wc = wid & 3, fr = lane & 15, fq = lane >> 4;
    const int K = g.K, nt = K / BK;
    unsigned voffA[2], voffB[2];
#pragma unroll
    for (int i = 0; i < 2; ++i) { int R, C; stage_rc(tid * 16 + i * 8192, R, C); const int Rb = Epi::PERM ? ((R & ~31) + perm32(R & 31)) : R;
        voffA[i] = AMODE == 1 ? (unsigned)((C >> 3) * NTOK + R) * 16u : (unsigned)(R * K + C) * 2u; voffB[i] = (unsigned)(bmap<BMODE>(Rb) * K + C) * 2u; }
    const size_t kstep = (size_t)(BK * 2);
    const size_t kstepA = AMODE == 1 ? (size_t)8 * NTOK * 16 : kstep;
    const size_t hstepB_nat = (size_t)HALF * K * 2;
    const size_t hstep = AMODE == 1 ? (size_t)HALF * 16 : hstepB_nat;
    const size_t hstepB = (BMODE == 16) ? (size_t)8 * K * 2 : hstepB_nat;
    const size_t tstep = 2 * hstep, tstepB = 2 * hstepB_nat;
    const unsigned ldsw = (unsigned)wid * 1024u;
    const int aoff = lds_byte(wr * 64 + fr, fq * 8), boff = lds_byte(wc * 32 + fr, fq * 8);
#define PG8_SA(b, h) (((b) * 2 + (h)) * HTB)
#define PG8_SB(b, h) ((4 + (b) * 2 + (h)) * HTB)
#define PG8_STAGE(bufoff, gbase, voff) do { _Pragma("unroll") for (int _i = 0; _i < 2; ++_i) \
        __builtin_amdgcn_global_load_lds((const unsigned*)((const char*)(gbase) + (voff)[_i]), (PG8_LAS unsigned*)(lds + (bufoff) + ldsw + _i * 8192), 16, 0, 0); } while (0)
#define PG8_LDA(dst, b, h) do { _Pragma("unroll") for (int m = 0; m < 4; ++m) _Pragma("unroll") for (int k = 0; k < 2; ++k) dst[m][k] = *(const PG8_LAS bf16x8*)(lds + PG8_SA(b, h) + aoff + m * 2048 + k * 1024); } while (0)
#define PG8_LDB(dst, b, h) do { _Pragma("unroll") for (int n = 0; n < 2; ++n) _Pragma("unroll") for (int k = 0; k < 2; ++k) dst[n][k] = *(const PG8_LAS bf16x8*)(lds + PG8_SB(b, h) + boff + n * 2048 + k * 1024); } while (0)
#define PG8_MMA(ai, bj, At, Bt) do { __builtin_amdgcn_s_setprio(1); _Pragma("unroll") for (int m = 0; m < 4; ++m) _Pragma("unroll") for (int n = 0; n < 2; ++n) _Pragma("unroll") for (int k = 0; k < 2; ++k) \
        acc[ai][bj][m][n] = __builtin_amdgcn_mfma_f32_16x16x32_bf16(Bt[n][k], At[m][k], acc[ai][bj][m][n], 0, 0, 0); __builtin_amdgcn_s_setprio(0); } while (0)
#define PG8_WAIT_V(n) asm volatile("s_waitcnt vmcnt(" #n ")" ::: "memory")
#define PG8_WAIT_L(n) asm volatile("s_waitcnt lgkmcnt(" #n ")" ::: "memory")
#define PG8_BAR __builtin_amdgcn_s_barrier()
#define PG8_SCHED __builtin_amdgcn_sched_barrier(0)
    Unit cur, nxt; int ui = 0;
    if (!S.next(0, cur)) return;
    f32x4 acc[2][2][4][2];
#pragma unroll
    for (int a = 0; a < 2; ++a)
#pragma unroll
        for (int b = 0; b < 2; ++b)
#pragma unroll
            for (int m = 0; m < 4; ++m)
#pragma unroll
                for (int n = 0; n < 2; ++n) acc[a][b][m][n] = (f32x4){0.f, 0.f, 0.f, 0.f};
    bf16x8 At[4][2], B0[2][2], B1[2][2];
    const char* cA = (const char*)g.A + (size_t)cur.pm * tstep; const char* cB = (const char*)g.Bt + (size_t)cur.pn * tstepB;
    S.a_ready(cur);
    if constexpr (SP2) {
        PG8_STAGE(PG8_SB(0, 0), cB, voffB); PG8_STAGE(PG8_SB(0, 1), cB + hstepB, voffB); PG8_STAGE(PG8_SA(0, 0), cA, voffA); PG8_STAGE(PG8_SA(0, 1), cA + hstep, voffA);
        if (wr == 1) PG8_BAR;
        PG8_WAIT_V(2); PG8_BAR;
        PG8_STAGE(PG8_SB(1, 0), cB + kstep, voffB); PG8_STAGE(PG8_SA(1, 0), cA + kstepA, voffA); PG8_STAGE(PG8_SB(1, 1), cB + hstepB + kstep, voffB);
        PG8_WAIT_V(6); PG8_BAR;
    } else {
        PG8_STAGE(PG8_SB(0, 0), cB, voffB); PG8_STAGE(PG8_SA(0, 0), cA, voffA); PG8_STAGE(PG8_SB(0, 1), cB + hstepB, voffB); PG8_STAGE(PG8_SA(0, 1), cA + hstep, voffA);
        if (wr == 1) PG8_BAR;
        PG8_WAIT_V(4); PG8_BAR;
        PG8_STAGE(PG8_SB(1, 0), cB + kstep, voffB); PG8_STAGE(PG8_SA(1, 0), cA + kstepA, voffA); PG8_STAGE(PG8_SB(1, 1), cB + hstepB + kstep, voffB);
        PG8_WAIT_V(6); PG8_BAR;
    }
    for (;;) {
        const bool has_next = S.next(ui + 1, nxt);
        const char* nA = has_next ? (const char*)g.A + (size_t)nxt.pm * tstep : cA; const char* nB = has_next ? (const char*)g.Bt + (size_t)nxt.pn * tstepB : cB;
        for (int t = 0; t < nt; t += 2) {
            const bool last = (t == nt - 2);
            const char* a1 = cA + (size_t)(t + 1) * kstepA;
            const char* a2 = last ? nA : cA + (size_t)(t + 2) * kstepA; const char* b2 = last ? nB : cB + (size_t)(t + 2) * kstep;
            const char* a3 = a2 + kstepA; const char* b3 = b2 + kstep;
            if (last && has_next) S.a_ready(nxt);
            if constexpr (Epi::MIDK > 0) { if (t == Epi::MIDK) E.mid(acc, cur, wr, wc, fr, fq); }
            if constexpr (SP2) {
            PG8_LDB(B0, 0, 0); PG8_LDB(B1, 0, 1); PG8_SCHED; PG8_LDA(At, 0, 0); PG8_STAGE(PG8_SA(1, 1), a1 + hstep, voffA);
            PG8_WAIT_V(8); PG8_WAIT_L(0); PG8_BAR; PG8_MMA(0, 0, At, B0); PG8_MMA(0, 1, At, B1); PG8_BAR; PG8_SCHED;
            PG8_LDA(At, 0, 1); PG8_STAGE(PG8_SB(0, 0), b2, voffB); PG8_STAGE(PG8_SB(0, 1), b2 + hstepB, voffB); PG8_STAGE(PG8_SA(0, 0), a2, voffA);
            PG8_WAIT_V(8); PG8_WAIT_L(0); PG8_BAR; PG8_MMA(1, 0, At, B0); PG8_MMA(1, 1, At, B1); PG8_BAR; PG8_SCHED;
            PG8_LDB(B0, 1, 0); PG8_LDB(B1, 1, 1); PG8_SCHED; PG8_LDA(At, 1, 0); PG8_STAGE(PG8_SA(0, 1), a2 + hstep, voffA);
            PG8_WAIT_V(8); PG8_WAIT_L(0); PG8_BAR; PG8_MMA(0, 0, At, B0); PG8_MMA(0, 1, At, B1); PG8_BAR; PG8_SCHED;
            PG8_LDA(At, 1, 1); PG8_STAGE(PG8_SB(1, 0), b3, voffB); PG8_STAGE(PG8_SB(1, 1), b3 + hstepB, voffB); PG8_STAGE(PG8_SA(1, 0), a3, voffA);
            PG8_WAIT_V(8); PG8_WAIT_L(0); PG8_BAR; PG8_MMA(1, 0, At, B0); PG8_MMA(1, 1, At, B1); PG8_BAR; PG8_SCHED;
            } else {
            PG8_LDB(B0, 0, 0); PG8_SCHED; PG8_LDA(At, 0, 0); PG8_STAGE(PG8_SA(1, 1), a1 + hstep, voffA);
            PG8_WAIT_L(8); PG8_BAR; PG8_WAIT_L(0); PG8_MMA(0, 0, At, B0); PG8_BAR; PG8_SCHED;
            PG8_LDB(B1, 0, 1); PG8_STAGE(PG8_SB(0, 0), b2, voffB);
            PG8_BAR; PG8_WAIT_L(0); PG8_MMA(0, 1, At, B1); PG8_BAR;
            PG8_LDA(At, 0, 1); PG8_STAGE(PG8_SA(0, 0), a2, voffA);
            PG8_BAR; PG8_WAIT_L(0); PG8_MMA(1, 0, At, B0); PG8_BAR; PG8_SCHED;
            PG8_STAGE(PG8_SB(0, 1), b2 + hstepB, voffB);
            PG8_WAIT_V(6); PG8_BAR; PG8_MMA(1, 1, At, B1); PG8_BAR;
            PG8_LDB(B0, 1, 0); PG8_SCHED; PG8_LDA(At, 1, 0); PG8_STAGE(PG8_SA(0, 1), a2 + hstep, voffA);
            PG8_WAIT_L(8); PG8_BAR; PG8_WAIT_L(0); PG8_MMA(0, 0, At, B0); PG8_BAR; PG8_SCHED;
            PG8_LDB(B1, 1, 1); PG8_STAGE(PG8_SB(1, 0), b3, voffB);
            PG8_BAR; PG8_WAIT_L(0); PG8_MMA(0, 1, At, B1); PG8_BAR;
            PG8_LDA(At, 1, 1); PG8_STAGE(PG8_SA(1, 0), a3, voffA);
            PG8_BAR; PG8_WAIT_L(0); PG8_MMA(1, 0, At, B0); PG8_BAR; PG8_SCHED;
            PG8_STAGE(PG8_SB(1, 1), b3 + hstepB, voffB);
            PG8_WAIT_V(6); PG8_BAR; PG8_MMA(1, 1, At, B1); PG8_BAR;
            }
        }
        if constexpr (ALIGN_EPI) { if (wr == 0) PG8_BAR; }
        if constexpr (!Epi::AFTER_DRAIN) { E(acc, cur, wr, wc, fr, fq); S.done(cur); }
        if (!has_next) break;
#pragma unroll
        for (int a = 0; a < 2; ++a)
#pragma unroll
            for (int b = 0; b < 2; ++b)
#pragma unroll
                for (int m = 0; m < 4; ++m)
#pragma unroll
                    for (int n = 0; n < 2; ++n) acc[a][b][m][n] = (f32x4){0.f, 0.f, 0.f, 0.f};
        cur = nxt; cA = nA; cB = nB; ++ui;
        if constexpr (ALIGN_EPI) { if (wr == 1) PG8_BAR; }
    }
    PG8_WAIT_V(0);
    if constexpr (!ALIGN_EPI) { if (wr == 0) PG8_BAR; }
    PG8_BAR;
#undef PG8_SA
#undef PG8_SB
#undef PG8_STAGE
#undef PG8_LDA
#undef PG8_LDB
#undef PG8_MMA
#undef PG8_WAIT_V
#undef PG8_WAIT_L
#undef PG8_BAR
#undef PG8_SCHED
}
}

constexpr int NWAVES = 8;
constexpr int N_LAUNCHES = MK_N_LAUNCHES;
constexpr int NPHASE = 8;

constexpr size_t MiB = 1u << 20;
constexpr size_t WS_CTL = 0, CTL_ZERO_BYTES = 1 * MiB;
constexpr size_t WS_MODP = 1 * MiB;
constexpr size_t WS_MOD = 4 * MiB;
constexpr size_t WS_BT = 4 * MiB + 256 * 1024;
constexpr size_t WS_ROWSQ = 5 * MiB;
constexpr size_t WS_LSE = 8 * MiB;
constexpr size_t WS_WMAIN = 16 * MiB;
constexpr size_t WS_WV = WS_WMAIN + (size_t)NMAIN * 1024 * 2;
constexpr size_t WS_WATT = 32 * MiB, WS_WPOOL = 33 * MiB, WS_WOUT = 34 * MiB, WS_PWBD = 36 * MiB;
constexpr size_t WS_H = 40 * MiB;
constexpr size_t WS_ACT = 104 * MiB;
constexpr size_t WS_END = 512 * MiB;
constexpr size_t ABYTES = 32 * MiB;
constexpr size_t WS_PART = WS_ACT + 1 * ABYTES;
constexpr size_t WS_MG = WS_ACT + 4 * ABYTES;
constexpr size_t WS_DUMMY = WS_H + 32 * MiB;
constexpr int CW_BAR = 4096;

#define GAS __attribute__((address_space(1)))
#define LAS __attribute__((address_space(3)))
typedef unsigned short bf16;
typedef unsigned v4u __attribute__((ext_vector_type(4)));
typedef unsigned v2u __attribute__((ext_vector_type(2)));
typedef float f32x4 __attribute__((ext_vector_type(4)));
typedef float f32x16 __attribute__((ext_vector_type(16)));
typedef short bf16x8 __attribute__((ext_vector_type(8)));
typedef GAS unsigned gu32;
#define RLX_AGENT __ATOMIC_RELAXED, __HIP_MEMORY_SCOPE_AGENT
#define LDS_WAIT() asm volatile("s_waitcnt lgkmcnt(0)" ::: "memory")
#define VM_WAIT() asm volatile("s_waitcnt vmcnt(0)" ::: "memory")

constexpr int RING_OFF = 0, RING_BYTES = 131072;
constexpr int LDSCTL_OFF = RING_BYTES, MISC_OFF = LDSCTL_OFF + 320;
constexpr int LDS_BYTES = 147456;

__device__ __forceinline__ unsigned pk2(float lo, float hi) { return pg8::cvt_pk_bf16(lo, hi); }
using pg8::bf_lo; using pg8::bf_hi;

#define XB_TMO      128
#define XB_XCNT(j)  (256  + 64 * (j))
#define XB_XSUB(j)  (1280 + 64 * (j))
#define XB_XGEN(j)  (2304 + 64 * (j))
#define XB_TOP      3328
#define XB_TOPGEN   3392
#define XCD_BAR_WORDS 3456
#define XB_SPIN_CAP (1u << 18)
__device__ __forceinline__ unsigned xb_ld(unsigned* p)              { return __hip_atomic_load(p, __ATOMIC_RELAXED, __HIP_MEMORY_SCOPE_AGENT); }
__device__ __forceinline__ unsigned xb_add(unsigned* p, unsigned v) { return __hip_atomic_fetch_add(p, v, __ATOMIC_RELAXED, __HIP_MEMORY_SCOPE_AGENT); }
__device__ __forceinline__ unsigned xb_xcc_id() { return (unsigned)__builtin_amdgcn_s_getreg((3 << 11) | 20) & 0xFu; }
#define XB_SPIN(cond, bar) do { unsigned _sp = 0; while (cond) { __builtin_amdgcn_s_sleep(1); \
    if ((++_sp & 255u) == 0u) { if (xb_ld(&(bar)[XB_TMO])) break; if (_sp > XB_SPIN_CAP) { atomicAdd(&(bar)[XB_TMO], 1u); break; } } } } while (0)
struct XcdBarrier { unsigned* bar; unsigned x; volatile LAS unsigned* st; };
__device__ __forceinline__ XcdBarrier xcd_barrier_post(unsigned* bar, volatile LAS unsigned* st) {
    XcdBarrier b; b.bar = bar; b.x = xb_xcc_id(); b.st = st;
    if (threadIdx.x == 0) (void)xb_add(&bar[XB_XCNT(b.x)], 1u);
    return b;
}
__device__ __forceinline__ void xcd_barrier_complete(unsigned* bar, unsigned x, unsigned& nloc, unsigned& nx) {
    const unsigned G = gridDim.x * gridDim.y * gridDim.z;
    unsigned sum, cnt, mine, sp = 0u;
    for (;;) {
        sum = 0u; cnt = 0u; mine = 0u;
#pragma unroll
        for (unsigned j = 0; j < 16; ++j) { const unsigned c = xb_ld(&bar[XB_XCNT(j)]); sum += c; cnt += (c > 0u) ? 1u : 0u; mine = (j == x) ? c : mine; }
        if (sum == G) break;
        __builtin_amdgcn_s_sleep(1);
        if ((++sp & 255u) == 0u) { if (xb_ld(&bar[XB_TMO])) break; if (sp > XB_SPIN_CAP) { atomicAdd(&bar[XB_TMO], 1u); break; } }
    }
    nloc = mine > 0u ? mine : 1u; nx = cnt > 0u ? cnt : 1u;
}
__device__ __forceinline__ void xcd_barrier(const XcdBarrier& b) {
    asm volatile("s_waitcnt vmcnt(0)" ::: "memory");
    __syncthreads();
    if (threadIdx.x == 0) {
        unsigned* bar = b.bar;
        __builtin_amdgcn_s_waitcnt(0);
        unsigned nloc = b.st[0], nx = b.st[1];
        if (nloc == 0u) { xcd_barrier_complete(bar, b.x, nloc, nx); b.st[0] = nloc; b.st[1] = nx; }
        const unsigned old = xb_add(&bar[XB_XSUB(b.x)], 1u);
        const unsigned gen = old / nloc;
        if (old + 1u == (gen + 1u) * nloc) {
            __builtin_amdgcn_fence(__ATOMIC_RELEASE, "agent");
            asm volatile("s_waitcnt vmcnt(0)" ::: "memory");
            const unsigned og = xb_add(&bar[XB_TOP], 1u);
            const unsigned tg = og / nx;
            if (og + 1u == (tg + 1u) * nx) xb_add(&bar[XB_TOPGEN], 1u);
            else XB_SPIN(xb_ld(&bar[XB_TOPGEN]) == tg, bar);
            __builtin_amdgcn_fence(__ATOMIC_ACQUIRE, "agent");
            xb_add(&bar[XB_XGEN(b.x)], 1u);
            asm volatile("s_waitcnt vmcnt(0)" ::: "memory");
        } else {
            XB_SPIN(xb_ld(&bar[XB_XGEN(b.x)]) == gen, bar);
            __builtin_amdgcn_fence(__ATOMIC_ACQUIRE, "agent");
            asm volatile("s_waitcnt vmcnt(0)" ::: "memory");
        }
    }
    __syncthreads();
}

struct Frame {
    LAS unsigned char* lds;
    volatile LAS unsigned* MISC;
    gu32* ctl;
    int tid, lane, wave;
    int vcu, G;
    unsigned char* ws;
};

__device__ __forceinline__ float wave_sum(float v) {
#pragma unroll
    for (int o = 1; o < 64; o <<= 1) v += __shfl_xor(v, o);
    return v;
}

__device__ __forceinline__ void transpose_item(const float* W, int K, int N, int k0, int n0, bf16* dstrow0, LAS float* scr, int lane, int ldd) {
#pragma unroll 8
    for (int i = 0; i < 32; ++i) { const int kk = 2 * i + (lane >> 5); scr[kk * 33 + (lane & 31)] = W[(size_t)(k0 + kk) * N + n0 + (lane & 31)]; }
    LDS_WAIT(); asm volatile("" ::: "memory");
    const int c = lane & 7;
#pragma unroll
    for (int j = 0; j < 4; ++j) { const int n = (lane >> 3) + 8 * j; const LAS float* s = scr + (8 * c) * 33 + n;
        v4u o; o.x = pk2(s[0 * 33], s[1 * 33]); o.y = pk2(s[2 * 33], s[3 * 33]); o.z = pk2(s[4 * 33], s[5 * 33]); o.w = pk2(s[6 * 33], s[7 * 33]);
        *(GAS v4u*)(dstrow0 + (size_t)n * ldd + k0 + 8 * c) = o; }
    LDS_WAIT(); asm volatile("" ::: "memory");
}
__device__ __forceinline__ int win_dest_row(int n) {
    if (n < 4608) { const int g = n / 1536, rem = n % 1536, type = rem / 512, j = rem % 512;
        return type == 2 ? NMAIN + g * 512 + j : g * 1024 + type * 512 + j; }
    return 3072 + (n - 4608);
}
__device__ __forceinline__ int t5_bucket(int n) {
    if (n < 16) return n;
    int large = 16 + (int)(logf((float)n / 16.0f) / logf(128.0f) * 16.0f);
    return large < 31 ? large : 31;
}
__device__ __forceinline__ void p0_prologue(Frame& F, const float* const* in) {
    LAS float* scr = (LAS float*)(F.lds + RING_OFF + F.wave * 16384);
    const int gw = F.vcu * NWAVES + F.wave, NGW = F.G * NWAVES;
    const float* w_in = in[5]; const float* pool_w = in[6]; const float* w_att = in[8]; const float* w_pool = in[9]; const float* w_out = in[10];
    bf16* WMAIN = (bf16*)(F.ws + WS_WMAIN);
    constexpr int I_IN = (1024 / 64) * (INW / 32), I_BR = (512 / 64) * (1024 / 32), I_OUT = (1024 / 64) * (1024 / 32);
    constexpr int NITEMS = I_IN + 2 * I_BR + I_OUT;
    for (int it = gw; it < NITEMS; it += NGW) {
        int r = it;
        if (r < I_IN) { const int nblk = INW / 32, kb = r / nblk, nb = r % nblk; transpose_item(w_in, 1024, INW, 64 * kb, 32 * nb, WMAIN + (size_t)win_dest_row(32 * nb) * 1024, scr, F.lane, 1024); continue; } r -= I_IN;
        if (r < I_BR) { const int nblk = 1024 / 32, kb = r / nblk, nb = r % nblk; transpose_item(w_att, 512, 1024, 64 * kb, 32 * nb, (bf16*)(F.ws + WS_WATT) + (size_t)(32 * nb) * 1024, scr, F.lane, 1024); continue; } r -= I_BR;
        if (r < I_BR) { const int nblk = 1024 / 32, kb = r / nblk, nb = r % nblk; transpose_item(w_pool, 512, 1024, 64 * kb, 32 * nb, (bf16*)(F.ws + WS_WATT) + (size_t)(32 * nb) * 1024 + 512, scr, F.lane, 1024); continue; } r -= I_BR;
        { const int nblk = 1024 / 32, kb = r / nblk, nb = r % nblk; transpose_item(w_out, 1024, 1024, 64 * kb, 32 * nb, (bf16*)(F.ws + WS_WOUT) + (size_t)(32 * nb) * 1024, scr, F.lane, 1024); }
    }
    { const float* c = in[1]; const float* w_ada = in[3]; float* MODP = (float*)(F.ws + WS_MODP);
      for (int task = gw; task < 48 * 32; task += NGW) { const int cg = task % 48, kc = task / 48, col = cg * 64 + F.lane;
          float a[8];
#pragma unroll
          for (int b = 0; b < 8; ++b) a[b] = 0.f;
#pragma unroll 8
          for (int k = 0; k < 32; ++k) { const int kk = kc * 32 + k; const float w = w_ada[(size_t)kk * 3072 + col];
#pragma unroll
              for (int b = 0; b < 8; ++b) a[b] += c[b * 1024 + kk] * w; }
#pragma unroll
          for (int b = 0; b < 8; ++b) MODP[((size_t)kc * 8 + b) * 3072 + col] = a[b]; } }
    const int gt = gw * 64 + F.lane, NT = NGW * 64;
    { bf16* PW = (bf16*)(F.ws + WS_PWBD);
      for (int ch = gt; ch < 4 * 4 * 8 * 64; ch += NT) { const int ln = ch & 63, ks = (ch >> 6) & 7, et = (ch >> 9) & 3, g = ch >> 11, e = et * 32 + (ln & 31), c0 = 16 * ks + 8 * (ln >> 5);
          const float* p = pool_w + (size_t)g * 16384 + (size_t)c0 * 128 + e;
          v4u o; o.x = pk2(p[0], p[128]); o.y = pk2(p[256], p[384]); o.z = pk2(p[512], p[640]); o.w = pk2(p[768], p[896]);
          *(GAS v4u*)(PW + (size_t)ch * 8) = o; } }
    { const float* rel_bias = in[11]; float* BD = (float*)(F.ws + WS_BT);
      for (int e = gt; e < 24 * 129; e += NT) { const int gh = e / 129, dist = e % 129, g = gh >> 3; const int dil = g == 0 ? 1 : (g == 1 ? 4 : 16);
          BD[e] = rel_bias[t5_bucket(dist * dil) * 24 + gh] * LOG2E; } }
}

__device__ __forceinline__ void p1_hrows(Frame& F, const float* const* in) {
    const float* x = in[0]; const float* norm_g = in[2]; const float* b_ada = in[4];
    const float* MODP = (const float*)(F.ws + WS_MODP);
    LAS float* av = (LAS float*)(F.lds + RING_OFF); LAS float* sv = av + 1024;
    const int wg = blockIdx.x, b = wg >> 5;
    for (int k = F.tid; k < 1024; k += NWAVES * 64) { float sh = b_ada[k], sc = b_ada[1024 + k], gt = b_ada[2048 + k];
        for (int kc = 0; kc < 32; ++kc) { const float* p = MODP + ((size_t)kc * 8 + b) * 3072; sh += p[k]; sc += p[1024 + k]; gt += p[2048 + k]; }
        av[k] = norm_g[k] * (1.f + sc); sv[k] = sh;
        if ((wg & 31) == 0) ((float*)(F.ws + WS_MOD))[b * 1024 + k] = gt; }
    LDS_WAIT(); __syncthreads();
    bf16* H = (bf16*)(F.ws + WS_H);
    for (int i = 0; i < 16; i += 4) { const int row0 = wg * 128 + F.wave * 16 + i;
        f32x4 v[4][4]; float s[4];
#pragma unroll
        for (int rr = 0; rr < 4; ++rr) { const GAS f32x4* xr = (const GAS f32x4*)(x + (size_t)(row0 + rr) * 1024) + F.lane;
#pragma unroll
            for (int j = 0; j < 4; ++j) v[rr][j] = xr[64 * j]; }
#pragma unroll
        for (int rr = 0; rr < 4; ++rr) { float t = 0.f;
#pragma unroll
            for (int j = 0; j < 4; ++j) t += (v[rr][j].x * v[rr][j].x + v[rr][j].y * v[rr][j].y) + (v[rr][j].z * v[rr][j].z + v[rr][j].w * v[rr][j].w);
            s[rr] = t; }
#pragma unroll
        for (int o = 1; o < 64; o <<= 1) {
#pragma unroll
            for (int rr = 0; rr < 4; ++rr) s[rr] += __shfl_xor(s[rr], o); }
#pragma unroll
        for (int rr = 0; rr < 4; ++rr) { const float rstd = 1.f / sqrtf(s[rr] * (1.f / 1024.f) + EPS);
            GAS v2u* o8 = (GAS v2u*)(H + (size_t)(row0 + rr) * 1024) + F.lane;
#pragma unroll
            for (int j = 0; j < 4; ++j) { const int k = 4 * F.lane + 256 * j; const f32x4 a = *(const LAS f32x4*)(av + k), sh = *(const LAS f32x4*)(sv + k);
                v2u w; w.x = pk2(v[rr][j].x * rstd * a.x + sh.x, v[rr][j].y * rstd * a.y + sh.y); w.y = pk2(v[rr][j].z * rstd * a.z + sh.z, v[rr][j].w * rstd * a.w + sh.w); o8[64 * j] = w; } } }
    __syncthreads();
}

constexpr int ATT_TBL = 0;
constexpr float ATT_THR = 8.0f;
__device__ __forceinline__ float max3f(float a, float b, float c) { return fmaxf(fmaxf(a, b), c); }
__device__ __forceinline__ void attn_chain(int lane, int g, int cc, char* QT, const char* KT, const char* VT, float* LSE, const LAS float* tbl, bool dummy, char* odummy) {
    const int q = lane & 31, hi = lane >> 5;
    const int sh = 2 * g, NB = 128 >> sh, bh = cc >> 5, ci = cc & 31, r = ci >> (5 - sh), n0 = 4 * (ci & ((32 >> sh) - 1));
    const int tbase = bh * 128 + r * NB, vbase = bh * 256 + r * 2 * NB;
    const LAS float* tb = tbl + (g * 8 + (bh & 7)) * 192 + (31 - q + 4 * hi);
    const LAS float* nb_ = tbl + 24 * 192 + (31 - q + 4 * hi);
    const int koff = lane * 16, voff = q * 32 + hi * 16;
    bf16x8 kr[3][4], vr[3][4], qf[4], qn[4];
#define ATT_LOADKV(i) do { const int lt_ = n0 + (i) / 5 - 4 + (i) % 5; const int ltc_ = lt_ < 0 ? 0 : lt_; \
        const char* kp_ = KT + ((size_t)(tbase + ltc_) << 12) + koff; const char* vp_ = VT + ((size_t)(vbase + 2 * ltc_) << 11) + voff; \
        _Pragma("unroll") for (int x_ = 0; x_ < 4; ++x_) kr[(i) % 3][x_] = *(const bf16x8*)(kp_ + x_ * 1024); \
        _Pragma("unroll") for (int x_ = 0; x_ < 4; ++x_) vr[(i) % 3][x_] = *(const bf16x8*)(vp_ + x_ * 1024); } while (0)
    { const char* qp = QT + ((size_t)(tbase + n0) << 12) + koff;
#pragma unroll
      for (int x = 0; x < 4; ++x) qf[x] = *(const bf16x8*)(qp + x * 1024); }
    ATT_LOADKV(0); ATT_LOADKV(1);
    float m = -3.0e38f, l = 0.f; f32x16 o0 = {}, o1 = {};
#pragma unroll
    for (int i = 0; i < 20; ++i) {
        const int nb = i / 5, kt = i % 5, n = n0 + nb, lt = n - 4 + kt;
        if (i + 2 < 20) ATT_LOADKV(i + 2);
        if (kt == 0 && nb < 3) { const char* qp = QT + ((size_t)(tbase + n + 1) << 12) + koff;
#pragma unroll
            for (int x = 0; x < 4; ++x) qn[x] = *(const bf16x8*)(qp + x * 1024); }
        const LAS float* tsel = lt < 0 ? nb_ : tb;
        f32x16 c;
#pragma unroll
        for (int e = 0; e < 16; ++e) c[e] = tsel[32 * kt + (e & 3) + 8 * (e >> 2)];
#pragma unroll
        for (int x = 0; x < 4; ++x) c = __builtin_amdgcn_mfma_f32_32x32x16_bf16(kr[i % 3][x], qf[x], c, 0, 0, 0);
        float rm = max3f(c[0], c[1], c[2]);
#pragma unroll
        for (int e = 3; e < 15; e += 2) rm = max3f(rm, c[e], c[e + 1]);
        rm = fmaxf(rm, c[15]);
        { auto rr = __builtin_amdgcn_permlane32_swap(__float_as_uint(rm), __float_as_uint(rm), false, false); rm = fmaxf(__uint_as_float(rr[0]), __uint_as_float(rr[1])); }
        if (__any(rm > m + ATT_THR)) { const float mn = fmaxf(m, rm), al = __builtin_amdgcn_exp2f(m - mn); m = mn; l *= al;
#pragma unroll
            for (int e = 0; e < 16; ++e) { o0[e] *= al; o1[e] *= al; } }
        float ps = 0.f;
#pragma unroll
        for (int e = 0; e < 16; ++e) { c[e] = __builtin_amdgcn_exp2f(c[e] - m); ps += c[e]; }
        l += ps;
        v4u p0, p1;
        p0.x = pk2(c[0], c[1]); p0.y = pk2(c[2], c[3]); p0.z = pk2(c[4], c[5]); p0.w = pk2(c[6], c[7]);
        p1.x = pk2(c[8], c[9]); p1.y = pk2(c[10], c[11]); p1.z = pk2(c[12], c[13]); p1.w = pk2(c[14], c[15]);
        const bf16x8 pf0 = __builtin_bit_cast(bf16x8, p0), pf1 = __builtin_bit_cast(bf16x8, p1);
        o0 = __builtin_amdgcn_mfma_f32_32x32x16_bf16(vr[i % 3][0], pf0, o0, 0, 0, 0);
        o1 = __builtin_amdgcn_mfma_f32_32x32x16_bf16(vr[i % 3][1], pf0, o1, 0, 0, 0);
        o0 = __builtin_amdgcn_mfma_f32_32x32x16_bf16(vr[i % 3][2], pf1, o0, 0, 0, 0);
        o1 = __builtin_amdgcn_mfma_f32_32x32x16_bf16(vr[i % 3][3], pf1, o1, 0, 0, 0);
        if (kt == 4) {
            { auto rr = __builtin_amdgcn_permlane32_swap(__float_as_uint(l), __float_as_uint(l), false, false); l = __uint_as_float(rr[0]) + __uint_as_float(rr[1]); }
            const float inv = 1.f / l;
            char* op = (dummy ? odummy : QT) + ((size_t)(tbase + n) << 12) + q * 16 + hi * 8;
#pragma unroll
            for (int r4 = 0; r4 < 4; ++r4) {
                v2u w0; w0.x = pk2(o0[4 * r4] * inv, o0[4 * r4 + 1] * inv); w0.y = pk2(o0[4 * r4 + 2] * inv, o0[4 * r4 + 3] * inv);
                v2u w1; w1.x = pk2(o1[4 * r4] * inv, o1[4 * r4 + 1] * inv); w1.y = pk2(o1[4 * r4 + 2] * inv, o1[4 * r4 + 3] * inv);
                *(v2u*)(op + (r4 >> 1) * 1024 + (r4 & 1) * 512) = w0; *(v2u*)(op + 2048 + (r4 >> 1) * 1024 + (r4 & 1) * 512) = w1; }
            if (hi == 0) { const size_t tok = (size_t)(bh >> 3) * SEQ + (size_t)((32 * n + q) << sh) + r; LSE[tok * 8 + (bh & 7)] = m + __builtin_amdgcn_logf(l); }
            m = -3.0e38f; l = 0.f; o0 = (f32x16){}; o1 = (f32x16){};
#pragma unroll
            for (int x = 0; x < 4; ++x) qf[x] = qn[x];
        }
    }
#undef ATT_LOADKV
}

__device__ __forceinline__ void p3_attention(Frame& F, bool dummy) {
    const int gw = F.vcu * NWAVES + F.wave;
    char* ACT = (char*)(F.ws + WS_ACT); float* LSE = dummy ? (float*)(F.ws + 12 * MiB) : (float*)(F.ws + WS_LSE);
    LAS float* tbl = (LAS float*)(F.lds + RING_OFF + ATT_TBL);
    { const float* BD = (const float*)(F.ws + WS_BT);
      for (int e = F.tid; e < 25 * 192; e += NWAVES * 64) { const int gh = e / 192, dist = 159 - (e % 192);
          tbl[e] = (gh < 24 && dist >= 0 && dist <= 128) ? BD[gh * 129 + dist] : NEG_BIG; }
      LDS_WAIT(); __syncthreads(); }
    for (int g = 0; g < 3; ++g) {
        char* Qg = ACT + (size_t)(g * 3) * ABYTES;
        attn_chain(F.lane, g, gw, Qg, Qg + ABYTES, Qg + 2 * ABYTES, LSE + (size_t)g * NTOK * 8, tbl, dummy, (char*)(F.ws + WS_DUMMY));
    }
    __syncthreads();
}
template <int G> __device__ __forceinline__ void poolmix_item(int lane, int T, const bf16* UT, bf16* ZP, bf16* DST, const bf16* PWF, const float* pscale) {
    constexpr int W = 2 << G;
    const int q = lane & 31, hi = lane >> 5, tok = T * 32 + q, t = tok & (SEQ - 1);
    f32x16 acc[4] = {};
#pragma unroll 2
    for (int ks = 0; ks < 8; ++ks) {
        const int c8 = G * 16 + 2 * ks + hi;
        const bf16* up = UT + ((size_t)c8 * NTOK + tok) * 8;
        v4u vv[W];
#pragma unroll
        for (int j = 0; j < W; ++j) vv[j] = *(const v4u*)(up - (j <= t ? j : 0) * 8);
        float sm[8];
#pragma unroll
        for (int e = 0; e < 8; ++e) sm[e] = 0.f;
#pragma unroll
        for (int j = 1; j < W; ++j) { const float wt = j <= t ? 1.f : 0.f; const v4u v = vv[j];
            sm[0] += wt * bf_lo(v.x); sm[1] += wt * bf_hi(v.x); sm[2] += wt * bf_lo(v.y); sm[3] += wt * bf_hi(v.y); sm[4] += wt * bf_lo(v.z); sm[5] += wt * bf_hi(v.z); sm[6] += wt * bf_lo(v.w); sm[7] += wt * bf_hi(v.w); }
        const float ic = 1.f / (float)((t + 1) < W ? (t + 1) : W), c0 = ic - 1.f; const v4u v0 = vv[0];
        v4u pw; pw.x = pk2(sm[0] * ic + c0 * bf_lo(v0.x), sm[1] * ic + c0 * bf_hi(v0.x)); pw.y = pk2(sm[2] * ic + c0 * bf_lo(v0.y), sm[3] * ic + c0 * bf_hi(v0.y));
        pw.z = pk2(sm[4] * ic + c0 * bf_lo(v0.z), sm[5] * ic + c0 * bf_hi(v0.z)); pw.w = pk2(sm[6] * ic + c0 * bf_lo(v0.w), sm[7] * ic + c0 * bf_hi(v0.w));
        const bf16x8 bfrag = __builtin_bit_cast(bf16x8, pw);
#pragma unroll
        for (int et = 0; et < 4; ++et) { const bf16x8 af = *(const bf16x8*)(PWF + ((size_t)((G * 4 + et) * 8 + ks) * 64 + lane) * 8);
            acc[et] = __builtin_amdgcn_mfma_f32_32x32x16_bf16(af, bfrag, acc[et], 0, 0, 0); }
    }
#pragma unroll
    for (int et = 0; et < 4; ++et)
#pragma unroll
        for (int r4 = 0; r4 < 4; ++r4) { const int col = G * 128 + et * 32 + 8 * r4 + 4 * hi; const size_t off = ((size_t)(col >> 3) * NTOK + tok) * 8 + 4 * hi;
            const v2u z = *(const v2u*)(ZP + off); const f32x4 ps = *(const f32x4*)(pscale + col);
            v2u w; w.x = pk2(acc[et][4 * r4] * ps.x * bf_lo(z.x), acc[et][4 * r4 + 1] * ps.y * bf_hi(z.x)); w.y = pk2(acc[et][4 * r4 + 2] * ps.z * bf_lo(z.y), acc[et][4 * r4 + 3] * ps.w * bf_hi(z.y));
            *(v2u*)(DST + off) = w; }
}
__device__ __forceinline__ void p3_poolmix(Frame& F, const float* pscale, bool dummy) {
    const int gw = F.vcu * NWAVES + F.wave, NGW = F.G * NWAVES;
    bf16* ACT = (bf16*)(F.ws + WS_ACT); const bf16* UT = ACT + 11 * pg8::ABUF; bf16* ZP = ACT + 10 * pg8::ABUF; const bf16* PWF = (const bf16*)(F.ws + WS_PWBD);
    bf16* DST = dummy ? (bf16*)(F.ws + WS_H) : ZP;
    for (int it = gw; it < 4096; it += NGW) { const int g = it >> 10, T = it & 1023;
        if (g == 0) poolmix_item<0>(F.lane, T, UT, ZP, DST, PWF, pscale);
        else if (g == 1) poolmix_item<1>(F.lane, T, UT, ZP, DST, PWF, pscale);
        else if (g == 2) poolmix_item<2>(F.lane, T, UT, ZP, DST, PWF, pscale);
        else poolmix_item<3>(F.lane, T, UT, ZP, DST, PWF, pscale); }
}
__device__ __forceinline__ void p4_combine(Frame& F, bool dummy) {
    const int gw = F.vcu * NWAVES + F.wave, NGW = F.G * NWAVES;
    const char* ACT = (const char*)(F.ws + WS_ACT); const float* LSE = (const float*)(F.ws + WS_LSE);
    const char* O0 = ACT; const char* O1 = ACT + 3 * ABYTES; const char* O2 = ACT + 6 * ABYTES; bf16* ZA = (bf16*)(F.ws + WS_ACT + 9 * ABYTES);
    bf16* DST = dummy ? (bf16*)(F.ws + WS_DUMMY) : ZA;
    const int q = F.lane & 31, hp = F.lane >> 5;
    for (int it = gw; it < 64 * 128 * 4; it += NGW) { const int dk = it & 3, lt0 = (it >> 2) & 127, bh = it >> 9, b = bh >> 3, h = bh & 7;
        const int tt = 32 * lt0 + q; const size_t tok = (size_t)b * SEQ + tt; const int inb = dk * 1024 + hp * 512;
        const float l0 = LSE[tok * 8 + h], l1 = LSE[((size_t)NTOK + tok) * 8 + h], l2 = LSE[((size_t)2 * NTOK + tok) * 8 + h];
        const v4u a = *(const v4u*)(O0 + ((size_t)(bh * 128 + lt0) << 12) + inb + q * 16);
        const v4u bb = *(const v4u*)(O1 + ((size_t)(bh * 128 + (tt & 3) * 32 + (tt >> 7)) << 12) + inb + ((tt >> 2) & 31) * 16);
        const v4u cc = *(const v4u*)(O2 + ((size_t)(bh * 128 + (tt & 15) * 8 + (tt >> 9)) << 12) + inb + ((tt >> 4) & 31) * 16);
        const size_t off = ((size_t)(h * 8 + dk * 2 + hp) * NTOK + tok) * 8;
        const v4u z = *(const v4u*)(ZA + off);
        const float mx = fmaxf(l0, fmaxf(l1, l2)); float w0 = __builtin_amdgcn_exp2f(l0 - mx), w1 = __builtin_amdgcn_exp2f(l1 - mx), w2 = __builtin_amdgcn_exp2f(l2 - mx);
        const float inv = 1.f / (w0 + w1 + w2); w0 *= inv; w1 *= inv; w2 *= inv;
        v4u o;
        o.x = pk2((w0 * bf_lo(a.x) + w1 * bf_lo(bb.x) + w2 * bf_lo(cc.x)) * bf_lo(z.x), (w0 * bf_hi(a.x) + w1 * bf_hi(bb.x) + w2 * bf_hi(cc.x)) * bf_hi(z.x));
        o.y = pk2((w0 * bf_lo(a.y) + w1 * bf_lo(bb.y) + w2 * bf_lo(cc.y)) * bf_lo(z.y), (w0 * bf_hi(a.y) + w1 * bf_hi(bb.y) + w2 * bf_hi(cc.y)) * bf_hi(z.y));
        o.z = pk2((w0 * bf_lo(a.z) + w1 * bf_lo(bb.z) + w2 * bf_lo(cc.z)) * bf_lo(z.z), (w0 * bf_hi(a.z) + w1 * bf_hi(bb.z) + w2 * bf_hi(cc.z)) * bf_hi(z.z));
        o.w = pk2((w0 * bf_lo(a.w) + w1 * bf_lo(bb.w) + w2 * bf_lo(cc.w)) * bf_lo(z.w), (w0 * bf_hi(a.w) + w1 * bf_hi(bb.w) + w2 * bf_hi(cc.w)) * bf_hi(z.w));
        *(GAS v4u*)(DST + off) = o; }
}
__device__ __forceinline__ void p7_final_norm(Frame& F, const float* final_g, float* out, float* dst) {
    const int gw = F.vcu * NWAVES + F.wave, NGW = F.G * NWAVES;
    const float* RS = (const float*)(F.ws + WS_ROWSQ);
    f32x4 gv[4];
#pragma unroll
    for (int j = 0; j < 4; ++j) gv[j] = ((const f32x4*)final_g)[F.lane + 64 * j];
    for (int row0 = gw * 4; row0 < NTOK; row0 += NGW * 4) {
        f32x4 v[4][4]; float s[4];
#pragma unroll
        for (int rr = 0; rr < 4; ++rr) { s[rr] = (F.lane < 16) ? RS[(size_t)(row0 + rr) * 16 + F.lane] : 0.f;
            const GAS f32x4* xr = (const GAS f32x4*)(out + (size_t)(row0 + rr) * 1024) + F.lane;
#pragma unroll
            for (int j = 0; j < 4; ++j) v[rr][j] = xr[64 * j]; }
#pragma unroll
        for (int o = 1; o < 16; o <<= 1) {
#pragma unroll
            for (int rr = 0; rr < 4; ++rr) s[rr] += __shfl_xor(s[rr], o); }
#pragma unroll
        for (int rr = 0; rr < 4; ++rr) { const float rstd = 1.f / sqrtf(__shfl(s[rr], 0) * (1.f / 1024.f) + EPS);
            GAS f32x4* dr = (GAS f32x4*)(dst + (size_t)(row0 + rr) * 1024) + F.lane;
#pragma unroll
            for (int j = 0; j < 4; ++j) dr[64 * j] = v[rr][j] * rstd * gv[j]; } }
}

struct Args { const float* in[13]; float* out; unsigned char* ws; int ph_lo, ph_hi, li, pad; };
__global__ void __launch_bounds__(NWAVES * 64, 2) mixer_fwd(Args args) {
    extern __shared__ __attribute__((aligned(16))) unsigned char lds[];
    Frame F;
    F.lds = (LAS unsigned char*)lds;
    F.MISC = (volatile LAS unsigned*)(F.lds + MISC_OFF);
    F.tid = threadIdx.x; F.lane = F.tid & 63; F.wave = __builtin_amdgcn_readfirstlane(F.tid >> 6);
    F.G = gridDim.x; { const int bx = blockIdx.x; F.vcu = (F.G % 8 == 0) ? (bx % 8) * (F.G / 8) + bx / 8 : bx; }
    F.ws = args.ws; F.ctl = (gu32*)(args.ws + WS_CTL);
    for (int u = F.tid; u < (LDS_BYTES - LDSCTL_OFF) / 4; u += NWAVES * 64) ((LAS unsigned*)(F.lds + LDSCTL_OFF))[u] = 0u;
    __syncthreads();
    XcdBarrier bar; bar.bar = (unsigned*)(F.ctl + CW_BAR); bar.x = 0; bar.st = nullptr;
    if (N_LAUNCHES == 1) bar = xcd_barrier_post((unsigned*)(F.ctl + CW_BAR), F.MISC + 8);
#define GRID_BAR() do { if (N_LAUNCHES == 1) xcd_barrier(bar); } while (0)
    const int lo = args.ph_lo, hi = args.ph_hi;
#define IN(k) (lo <= (k) && (k) < hi)
#define BOTH(k) (IN(k) && IN((k) + 1))
    bf16* ACT = (bf16*)(F.ws + WS_ACT);
    const int G = F.G, bid = (int)blockIdx.x;

    const bool dm = args.pad != 0;
    if (IN(0)) { p0_prologue(F, args.in); if (BOTH(0)) GRID_BAR(); }
    if (IN(1)) { p1_hrows(F, args.in); if (BOTH(1)) GRID_BAR(); }
    if (IN(2)) {
        { pg8::Gemm g{(const bf16*)(F.ws + WS_H), (const bf16*)(F.ws + WS_WMAIN), NTOK, NMAIN, 1024}; pg8::StaticOrder S; S.init(NTOK, NMAIN, G, bid);
          pg8::EpiProj E{ACT, (bf16*)args.out};
          pg8::gemm_phase<pg8::EpiProj, pg8::StaticOrder, true, true, 0>(F.lds + RING_OFF, g, S, E); }
        { pg8::Gemm g{(const bf16*)(F.ws + WS_WV), (const bf16*)(F.ws + WS_H), 512, NTOK, 1024}; pg8::StaticOrder S; S.init(512, NTOK, G, bid);
          pg8::EpiVT<1> E{ACT + 2 * pg8::ABUF};
          pg8::gemm_phase<pg8::EpiVT<1>, pg8::StaticOrder, false, true, 1>(F.lds + RING_OFF, g, S, E); }
        { pg8::Gemm g{(const bf16*)(F.ws + WS_WV) + (size_t)512 * 1024, (const bf16*)(F.ws + WS_H), 512, NTOK, 1024}; pg8::StaticOrder S; S.init(512, NTOK, G, bid);
          pg8::EpiVT<4> E{ACT + 5 * pg8::ABUF};
          pg8::gemm_phase<pg8::EpiVT<4>, pg8::StaticOrder, false, true, 4>(F.lds + RING_OFF, g, S, E); }
        { pg8::Gemm g{(const bf16*)(F.ws + WS_WV) + (size_t)1024 * 1024, (const bf16*)(F.ws + WS_H), 512, NTOK, 1024}; pg8::StaticOrder S; S.init(512, NTOK, G, bid);
          pg8::EpiVT<16> E{ACT + 8 * pg8::ABUF};
          pg8::gemm_phase<pg8::EpiVT<16>, pg8::StaticOrder, false, true, 16>(F.lds + RING_OFF, g, S, E); }
        if (BOTH(2)) GRID_BAR();
    }
    if (IN(3)) { if (!(dm && PROBE_SUB == 2)) p3_attention(F, dm); if (!(dm && PROBE_SUB == 1)) p3_poolmix(F, args.in[7], dm); if (BOTH(3)) GRID_BAR(); }
    if (IN(4)) {
        p4_combine(F, dm);
        if (BOTH(4)) GRID_BAR();
    }
    if (IN(5)) {
        { pg8::Gemm g{ACT + 9 * pg8::ABUF, (const bf16*)(F.ws + WS_WATT), NTOK, 1024, 1024}; pg8::StaticOrder S; S.init(NTOK, 1024, G, bid);
          pg8::EpiMerge E{(const bf16*)args.out, (const bf16*)args.out + (size_t)NTOK * 1024, (bf16*)(F.ws + WS_MG)};
          pg8::gemm_phase<pg8::EpiMerge, pg8::StaticOrder, true, true, 0, 1>(F.lds + RING_OFF, g, S, E); }
        if (BOTH(5)) GRID_BAR();
    }
    if (IN(6)) {
        { pg8::Gemm g{(const bf16*)(F.ws + WS_MG), (const bf16*)(F.ws + WS_WOUT), NTOK, 1024, 1024}; pg8::StaticOrder S; S.init(NTOK, 1024, G, bid);
          pg8::EpiFinal E{args.in[0], args.out, (const float*)(F.ws + WS_MOD), (float*)(F.ws + WS_ROWSQ)};
          pg8::gemm_phase<pg8::EpiFinal, pg8::StaticOrder, true, true, 0>(F.lds + RING_OFF, g, S, E); }
        if (BOTH(6)) GRID_BAR();
    }
    if (IN(7)) { p7_final_norm(F, args.in[12], args.out, dm ? (float*)(F.ws + WS_ACT) : args.out); }
#undef IN
#undef BOTH
}

extern "C" void kernel_launch(void* const* d_in, const int* in_sizes, int n_in, void* d_out, int out_size, void* d_ws, size_t ws_size, hipStream_t stream) {
    static int grid = 0;
    if (grid == 0) {
        if (n_in != 13 || in_sizes[0] != NTOK * DM || out_size != NTOK * DM || ws_size < WS_END) { fprintf(stderr, "kernel_launch: unexpected shapes (n_in %d, in0 %d, out %d, ws %zu); nothing launched\n", n_in, n_in > 0 ? in_sizes[0] : -1, out_size, ws_size); grid = -1; return; }
        int dev = 0, cus = 0, per_cu = 0;
        if (hipGetDevice(&dev) != hipSuccess || hipDeviceGetAttribute(&cus, hipDeviceAttributeMultiprocessorCount, dev) != hipSuccess) { grid = -1; return; }
        if (hipFuncSetAttribute((const void*)mixer_fwd, hipFuncAttributeMaxDynamicSharedMemorySize, LDS_BYTES) != hipSuccess) { fprintf(stderr, "kernel_launch: hipFuncSetAttribute failed\n"); grid = -1; return; }
        if (hipOccupancyMaxActiveBlocksPerMultiprocessor(&per_cu, (const void*)mixer_fwd, NWAVES * 64, LDS_BYTES) != hipSuccess || per_cu < 1) { fprintf(stderr, "kernel_launch: occupancy query says %d blocks per CU\n", per_cu); (void)hipGetLastError(); grid = -1; return; }
        grid = cus;
        if (grid != 256) { fprintf(stderr, "kernel_launch: built for 256 CUs, device has %d\n", cus); grid = -1; return; }
    }
    if (grid < 0) return;
    if (hipMemsetAsync((char*)d_ws + WS_CTL, 0, CTL_ZERO_BYTES, stream) != hipSuccess) return;
    Args a{};
    for (int i = 0; i < 13; ++i) a.in[i] = (const float*)d_in[i];
    a.out = (float*)d_out; a.ws = (unsigned char*)d_ws;
    if (N_LAUNCHES == 1) {
        a.ph_lo = 0; a.ph_hi = NPHASE; a.li = 0;
        void* kargs[] = {&a};
        hipError_t e = hipLaunchCooperativeKernel((const void*)mixer_fwd, dim3(grid), dim3(NWAVES * 64), kargs, LDS_BYTES, stream);
        if (e != hipSuccess) fprintf(stderr, "kernel_launch: cooperative launch failed: %s\n", hipGetErrorString(e));
    } else {
        for (int li = 0; li < NPHASE; ++li) { a.ph_lo = li; a.ph_hi = li + 1; a.li = li;
            for (int rep = (PROBE_DUP >> li) & 1; rep >= 0; --rep) { a.pad = rep;
                hipLaunchKernelGGL(mixer_fwd, dim3(grid), dim3(NWAVES * 64), LDS_BYTES, stream, a); } }
    }
}
```
